# Optimizing an MI355X kernel written in HIP

```python
import math
import jax, jax.numpy as jnp
from jax import lax
import numpy as np

D_MODEL = 2048
BATCH = 16
SEQ = 256
DEPTH = 4
DEC_BATCH = 2
DEC_SEQ = 1024
PAST_LEN = 512

GRID_W = 64
N_HEADS = 4
HEAD_DIM = 128
V_DIM = 2 * HEAD_DIM
ATTN_W = N_HEADS * 2 * HEAD_DIM
CONV_W = 512
CONV_K = 31
SC_W = 512
SC_K = 3
F_W = 512
F_GROUPS = 4
F_GROUP = F_W // F_GROUPS
N_BRANCH = 4
D_IN = 2 * CONV_W + 3 * ATTN_W + 3 * SC_W + F_W
D_FF = ((8 * D_MODEL + 3 * 256 - 1) // (3 * 256)) * 256
ROPE_THETA = 10000.0
EPS = 1e-6
Q_BLOCK = 128

kernel_name = 'hybrid_diffusion_prefix_trunk_step'


def _rmsnorm(x, g):
    xf = x.astype(jnp.float32)
    y = xf * lax.rsqrt(jnp.mean(xf * xf, axis=-1, keepdims=True) + EPS)
    return (y * g.astype(jnp.float32)).astype(x.dtype)


def _layernorm(x, g, b):
    xf = x.astype(jnp.float32)
    mu = jnp.mean(xf, axis=-1, keepdims=True)
    xc = xf - mu
    y = xc * lax.rsqrt(jnp.mean(xc * xc, axis=-1, keepdims=True) + EPS)
    return (y * g.astype(jnp.float32) + b.astype(jnp.float32)).astype(x.dtype)


def _dwconv(x, w):
    pad = w.shape[0] // 2
    return lax.conv_general_dilated(
        x, w[:, None, :].astype(x.dtype), window_strides=(1,), padding=[(pad, pad)],
        dimension_numbers=('NWC', 'WIO', 'NWC'), feature_group_count=x.shape[-1])


def _axial_rope_tables(n_tok):
    rows = n_tok // GRID_W
    t = jnp.arange(rows * GRID_W)
    row = (t // GRID_W).astype(jnp.float32)
    col = (t % GRID_W).astype(jnp.float32)
    half = HEAD_DIM // 2
    inv = ROPE_THETA ** (-jnp.arange(0, half, 2, dtype=jnp.float32) / half)
    ar = row[:, None] * inv
    ac = col[:, None] * inv
    ang = jnp.concatenate([ar, ar, ac, ac], axis=-1)
    return jnp.cos(ang), jnp.sin(ang)


def _rotate_half(x):
    x1, x2 = jnp.split(x, 2, axis=-1)
    return jnp.concatenate([-x2, x1], axis=-1)


def _apply_rope(x, cos, sin):
    half = HEAD_DIM // 2
    rot = jnp.concatenate([_rotate_half(x[..., :half]), _rotate_half(x[..., half:])], axis=-1)
    c = cos[:, None, None, :]
    s = sin[:, None, None, :]
    return (x.astype(jnp.float32) * c + rot.astype(jnp.float32) * s).astype(x.dtype)


def _diff_attention(q, k, v, lam):
    b, tq = q.shape[0], q.shape[1]
    nblk = tq // Q_BLOCK
    qb = jnp.moveaxis(q.reshape(b, nblk, Q_BLOCK, N_HEADS, 2, HEAD_DIM), 1, 0)
    scale = HEAD_DIM ** -0.5

    def blk(qi):
        s = jnp.einsum('bqhmd,bkhmd->bhmqk', qi, k).astype(jnp.float32) * scale
        p = jax.nn.softmax(s, axis=-1)
        a = p[:, :, 0] - lam * p[:, :, 1]
        return jnp.einsum('bhqk,bkhe->bqhe', a.astype(v.dtype), v)

    o = lax.map(blk, qb)
    return jnp.moveaxis(o, 0, 1).reshape(b, tq, N_HEADS, V_DIM)


def _fourier_mix(u):
    b, t = u.shape[0], u.shape[1]
    ug = u.reshape(b, t, F_GROUPS, F_GROUP).astype(jnp.float32)
    f = jnp.fft.fft2(ug, axes=(1, 3), norm='ortho').real
    return f.reshape(b, t, F_W).astype(u.dtype)


def _layer(x, cvec, ctx_k, ctx_v, l, lw):
    bsz, t = x.shape[0], x.shape[1]
    mod = (jax.nn.silu(cvec) @ lw['w_ada'] + lw['b_ada']).reshape(-1, 1, 6 * D_MODEL)
    sh_m, sc_m, g_m, sh_f, sc_f, g_f = jnp.split(mod, 6, axis=-1)

    h = _rmsnorm(x, lw['g_pre_mix']) * (1 + sc_m) + sh_m
    proj = h @ lw['w_in']
    cuts = [2 * CONV_W, 2 * CONV_W + ATTN_W, 2 * CONV_W + 2 * ATTN_W, 2 * CONV_W + 3 * ATTN_W,
            2 * CONV_W + 3 * ATTN_W + SC_W, 2 * CONV_W + 3 * ATTN_W + 2 * SC_W,
            2 * CONV_W + 3 * ATTN_W + 3 * SC_W]
    a_in, q, k, v, s_b, s_c, s_x, d_in = jnp.split(proj, cuts, axis=-1)

    a_val, a_gate = jnp.split(a_in, 2, axis=-1)
    a = _dwconv(a_val * jax.nn.sigmoid(a_gate), lw['conv_a_w']) + lw['conv_a_b']
    a = jax.nn.silu(_layernorm(a, lw['ln_a_g'], lw['ln_a_b']))
    y_a = a @ lw['w_a_out']

    q = q.reshape(bsz, t, N_HEADS, 2, HEAD_DIM)
    k = k.reshape(bsz, t, N_HEADS, 2, HEAD_DIM)
    v = v.reshape(bsz, t, N_HEADS, V_DIM)
    lam_init = 0.8 - 0.6 * math.exp(-0.3 * l)
    lam = (jnp.exp(jnp.sum(lw['lam_q1'].astype(jnp.float32) * lw['lam_k1'].astype(jnp.float32)))
           - jnp.exp(jnp.sum(lw['lam_q2'].astype(jnp.float32) * lw['lam_k2'].astype(jnp.float32)))
           + lam_init)
    if ctx_k is None:
        q_r, k_all, v_all = q, k, v
        new_kv = (k.reshape(bsz, t, N_HEADS, 2 * HEAD_DIM), v)
    else:
        cos, sin = _axial_rope_tables(t)
        q_r = _apply_rope(q, cos, sin)
        k_all = jnp.concatenate([ctx_k.reshape(bsz, -1, N_HEADS, 2, HEAD_DIM), _apply_rope(k, cos, sin)], axis=1)
        v_all = jnp.concatenate([ctx_v, v], axis=1)
        new_kv = None
    o = _diff_attention(q_r, k_all, v_all, lam)
    o = _rmsnorm(o, lw['subln_g']) * (1 - lam_init)
    y_b = o.reshape(bsz, t, ATTN_W) @ lw['w_b_out']

    y_c = (s_b * _dwconv(s_c * s_x, lw['conv_c_w'])) @ lw['w_c_out']

    y_d = _fourier_mix(d_in) @ lw['w_d_out']

    gates = jax.nn.sigmoid(h @ lw['w_gate'] + lw['b_gate']).reshape(bsz, t, N_BRANCH, D_MODEL)
    merged = gates[:, :, 0] * y_a + gates[:, :, 1] * y_b + gates[:, :, 2] * y_c + gates[:, :, 3] * y_d
    mix = merged @ lw['w_o']
    x = x + g_m * _rmsnorm(mix, lw['g_post_mix'])

    h2 = _rmsnorm(x, lw['g_pre_ffn']) * (1 + sc_f) + sh_f
    up, gt = jnp.split(h2 @ lw['w_ffn_up'], 2, axis=-1)
    f = (jax.nn.silu(gt) * up) @ lw['w_ffn_down']
    x = x + g_f * _rmsnorm(f, lw['g_post_ffn'])
    return x, new_kv


def setup_inputs(seed: int = 0) -> dict:
    key = jax.random.key(seed)
    ks = iter(jax.random.split(key, 40))

    def nrm(shape, scale):
        return jax.random.normal(next(ks), shape, jnp.float32) * scale

    def gain(shape):
        return 1.0 + nrm(shape, 0.05)

    L = DEPTH
    return {
        'x_prompt': nrm((BATCH, SEQ, D_MODEL), 1.0),
        'x_sample': nrm((DEC_BATCH, DEC_SEQ, D_MODEL), 1.0),
        'cache_k': nrm((DEC_BATCH, DEPTH, PAST_LEN, N_HEADS, 2 * HEAD_DIM), 1.0),
        'cache_v': nrm((DEC_BATCH, DEPTH, PAST_LEN, N_HEADS, 2 * HEAD_DIM), 1.0),
        'c': nrm((DEC_BATCH, D_MODEL), 1.0),
        'c_ctx': nrm((D_MODEL,), 1.0),
        'w_ada': nrm((L, D_MODEL, 6 * D_MODEL), 0.5 * D_MODEL ** -0.5),
        'b_ada': nrm((L, 6 * D_MODEL), 0.01),
        'g_pre_mix': gain((L, D_MODEL)),
        'g_post_mix': gain((L, D_MODEL)),
        'g_pre_ffn': gain((L, D_MODEL)),
        'g_post_ffn': gain((L, D_MODEL)),
        'w_in': nrm((L, D_MODEL, D_IN), D_MODEL ** -0.5),
        'conv_a_w': nrm((L, CONV_K, CONV_W), CONV_K ** -0.5),
        'conv_a_b': nrm((L, CONV_W), 0.01),
        'ln_a_g': gain((L, CONV_W)),
        'ln_a_b': nrm((L, CONV_W), 0.01),
        'w_a_out': nrm((L, CONV_W, D_MODEL), CONV_W ** -0.5),
        'lam_q1': nrm((L, HEAD_DIM), 0.1),
        'lam_k1': nrm((L, HEAD_DIM), 0.1),
        'lam_q2': nrm((L, HEAD_DIM), 0.1),
        'lam_k2': nrm((L, HEAD_DIM), 0.1),
        'subln_g': gain((L, V_DIM)),
        'w_b_out': nrm((L, ATTN_W, D_MODEL), ATTN_W ** -0.5),
        'conv_c_w': nrm((L, SC_K, SC_W), SC_K ** -0.5),
        'w_c_out': nrm((L, SC_W, D_MODEL), SC_W ** -0.5),
        'w_d_out': nrm((L, F_W, D_MODEL), F_W ** -0.5),
        'w_gate': nrm((L, D_MODEL, N_BRANCH * D_MODEL), D_MODEL ** -0.5),
        'b_gate': nrm((L, N_BRANCH * D_MODEL), 0.01),
        'w_o': nrm((L, D_MODEL, D_MODEL), D_MODEL ** -0.5),
        'w_ffn_up': nrm((L, D_MODEL, 2 * D_FF), D_MODEL ** -0.5),
        'w_ffn_down': nrm((L, D_FF, D_MODEL), D_FF ** -0.5),
    }


def reference(x_prompt, x_sample, cache_k, cache_v, c, c_ctx, w_ada, b_ada, g_pre_mix, g_post_mix,
              g_pre_ffn, g_post_ffn, w_in, conv_a_w, conv_a_b, ln_a_g, ln_a_b, w_a_out,
              lam_q1, lam_k1, lam_q2, lam_k2, subln_g, w_b_out, conv_c_w, w_c_out, w_d_out,
              w_gate, b_gate, w_o, w_ffn_up, w_ffn_down):
    y_prompt = x_prompt
    y_sample = x_sample
    ks_new = []
    vs_new = []
    for l in range(DEPTH):
        lw = {
            'w_ada': w_ada[l], 'b_ada': b_ada[l],
            'g_pre_mix': g_pre_mix[l], 'g_post_mix': g_post_mix[l],
            'g_pre_ffn': g_pre_ffn[l], 'g_post_ffn': g_post_ffn[l],
            'w_in': w_in[l],
            'conv_a_w': conv_a_w[l], 'conv_a_b': conv_a_b[l],
            'ln_a_g': ln_a_g[l], 'ln_a_b': ln_a_b[l], 'w_a_out': w_a_out[l],
            'lam_q1': lam_q1[l], 'lam_k1': lam_k1[l], 'lam_q2': lam_q2[l], 'lam_k2': lam_k2[l],
            'subln_g': subln_g[l], 'w_b_out': w_b_out[l],
            'conv_c_w': conv_c_w[l], 'w_c_out': w_c_out[l],
            'w_d_out': w_d_out[l],
            'w_gate': w_gate[l], 'b_gate': b_gate[l], 'w_o': w_o[l],
            'w_ffn_up': w_ffn_up[l], 'w_ffn_down': w_ffn_down[l],
        }
        y_prompt, kv = _layer(y_prompt, c_ctx, None, None, l, lw)
        ks_new.append(kv[0])
        vs_new.append(kv[1])
        y_sample, _ = _layer(y_sample, c, cache_k[:, l], cache_v[:, l], l, lw)
    new_k = jnp.stack(ks_new, axis=1)
    new_v = jnp.stack(vs_new, axis=1)
    return (y_prompt, y_sample, new_k, new_v)
```

```cpp
#include <hip/hip_runtime.h>
#include <cstdio>
#include <cstdint>

#ifndef MK_LAYERS
#define MK_LAYERS 4
#endif

#define GAS __attribute__((address_space(1)))
#define LAS __attribute__((address_space(3)))
typedef unsigned short bf16;
typedef unsigned v4u __attribute__((ext_vector_type(4)));
typedef unsigned v2u __attribute__((ext_vector_type(2)));
typedef float f32x4 __attribute__((ext_vector_type(4)));
typedef float f32x8 __attribute__((ext_vector_type(8)));
typedef float f32x16 __attribute__((ext_vector_type(16)));
typedef short bf16x8 __attribute__((ext_vector_type(8)));
typedef short s16x4 __attribute__((ext_vector_type(4)));
typedef GAS unsigned gu32;
#define RLX_AGENT __ATOMIC_RELAXED, __HIP_MEMORY_SCOPE_AGENT
#define LDS_WAIT() asm volatile("s_waitcnt lgkmcnt(0)" ::: "memory")
#define VM_WAIT() asm volatile("s_waitcnt vmcnt(0)" ::: "memory")
__device__ __forceinline__ unsigned f2bf(float f) { unsigned u = __builtin_bit_cast(unsigned, f); return (u + 0x7fffu + ((u >> 16) & 1u)) >> 16; }
__device__ __forceinline__ unsigned pk2(float lo, float hi) { return f2bf(lo) | (f2bf(hi) << 16); }
__device__ __forceinline__ float bf_lo(unsigned w) { return __builtin_bit_cast(float, w << 16); }
__device__ __forceinline__ float bf_hi(unsigned w) { return __builtin_bit_cast(float, w & 0xffff0000u); }
__device__ __forceinline__ float bf2f(bf16 b) { return __builtin_bit_cast(float, ((unsigned)b) << 16); }
__device__ __forceinline__ float sigmoid_f(float x) { return __builtin_amdgcn_rcpf(1.0f + __builtin_amdgcn_exp2f(-1.4426950408889634f * x)); }
typedef float f32x2c_t __attribute__((ext_vector_type(2)));
typedef __bf16 bf16x2c_t __attribute__((ext_vector_type(2)));
__device__ __forceinline__ unsigned cvt_pk_bf16_c(float lo, float hi) { f32x2c_t v = {lo, hi}; bf16x2c_t b = __builtin_convertvector(v, bf16x2c_t); return __builtin_bit_cast(unsigned, b); }
__device__ __forceinline__ float wave_sum(float v) {
#pragma unroll
    for (int o = 1; o < 64; o <<= 1) v += __shfl_xor(v, o);
    return v;
}

namespace pg8 {
#define PG8_LAS __attribute__((address_space(3)))
typedef unsigned short bf16_t;
typedef unsigned u32x4 __attribute__((ext_vector_type(4)));
typedef unsigned u32x2 __attribute__((ext_vector_type(2)));
constexpr int BM = 256, BK = 64, HALF = 128, HTB = HALF * BK * 2  , STAGE_BYTES = 8 * HTB, NXCD = 8, WGM = 8;

__host__ __device__ __forceinline__ int lds_byte(int r, int c) { const int st = (r >> 4) * 2 + (c >> 5), rr = r & 15, cc = c & 31, ob = rr * 64 + cc * 2; return st * 1024 + (ob ^ (((ob >> 9) & 1) << 5)); }
__host__ __device__ __forceinline__ void stage_rc(int b, int& R, int& C) { const int st = b / 1024, sb = b % 1024, swz = sb ^ (((sb >> 9) & 1) << 5); R = (st >> 1) * 16 + swz / 64; C = (st & 1) * 32 + (swz % 64) / 2; }
__host__ __device__ __forceinline__ int perm32(int rho) { const int n = rho >> 4, i = rho & 15; return 8 * (i >> 2) + 4 * n + (i & 3); }

struct Unit { int pm, pn, aux, nt; const char* A; const char* B; };

__device__ __forceinline__ bool tile_order(long L, int nM, int nN, int& pm, int& pn) {
    const int nwg = nM * nN; if (L >= nwg) return false;
    int wgid = (int)L; { const int q = nwg / NXCD, r = nwg % NXCD, xcd = wgid % NXCD, off = wgid / NXCD; wgid = (xcd < r ? xcd * (q + 1) : r * (q + 1) + (xcd - r) * q) + off; }
    const int nig = WGM * nN, gid = wgid / nig, fm = gid * WGM, gsz = (nM - fm) < WGM ? (nM - fm) : WGM;
    pm = fm + ((wgid % nig) % gsz); pn = (wgid % nig) / gsz; return true;
}
struct TileSched {
    int nM, nN, G, c, nt; const char* A; const char* B; size_t strideA, strideB;
    __device__ __forceinline__ bool next(int i, Unit& u) const {
        int pm, pn; if (!tile_order((long)i * G + c, nM, nN, pm, pn)) return false;
        u.pm = pm; u.pn = pn; u.aux = 0; u.nt = nt; u.A = A + (size_t)pm * strideA; u.B = B + (size_t)pn * strideB; return true;
    }
};

__device__ __forceinline__ unsigned cvt_pk_bf16(float lo, float hi) { return cvt_pk_bf16_c(lo, hi); }

template <class Epi, class Sched, bool ALIGN_EPI = true, bool SP2 = true>
__device__ __forceinline__ void gemm_stream(PG8_LAS unsigned char* lds, const int tid, const int lda, const int ldb, const Sched& S, const Epi& E) {
    const int wid = __builtin_amdgcn_readfirstlane(tid >> 6), lane = tid & 63, wr = wid >> 2, wc = wid & 3, fr = lane & 15, fq = lane >> 4;
    unsigned voffA[2], voffB[2];
#pragma unroll
    for (int i = 0; i < 2; ++i) { int R, C; stage_rc(tid * 16 + i * 8192, R, C); const int Rb = Epi::PERM ? ((R & ~31) + perm32(R & 31)) : R;
        voffA[i] = (unsigned)(R * lda + C) * 2u; voffB[i] = (unsigned)(Rb * ldb + C) * 2u; }
    const size_t kstep = (size_t)(BK * 2);
    const size_t hstepA = (size_t)HALF * lda * 2, hstepB = (size_t)HALF * ldb * 2;
    const unsigned ldsw = (unsigned)wid * 1024u;
    const int aoff = lds_byte(wr * 64 + fr, fq * 8), boff = lds_byte(wc * 32 + fr, fq * 8);
#define PG8_SA(b, h) (((b) * 2 + (h)) * HTB)
#define PG8_SB(b, h) ((4 + (b) * 2 + (h)) * HTB)
#define PG8_STAGE(bufoff, gbase, voff) do { _Pragma("unroll") for (int _i = 0; _i < 2; ++_i) \
        __builtin_amdgcn_global_load_lds((const unsigned*)((const char*)(gbase) + (voff)[_i]), (PG8_LAS unsigned*)(lds + (bufoff) + ldsw + _i * 8192), 16, 0, 0); } while (0)
#define PG8_LDA(dst, b, h) do { _Pragma("unroll") for (int m = 0; m < 4; ++m) _Pragma("unroll") for (int k = 0; k < 2; ++k) dst[m][k] = *(const PG8_LAS bf16x8*)(lds + PG8_SA(b, h) + aoff + m * 2048 + k * 1024); } while (0)
#define PG8_LDB(dst, b, h) do { _Pragma("unroll") for (int n = 0; n < 2; ++n) _Pragma("unroll") for (int k = 0; k < 2; ++k) dst[n][k] = *(const PG8_LAS bf16x8*)(lds + PG8_SB(b, h) + boff + n * 2048 + k * 1024); } while (0)
#define PG8_MMA(ai, bj, At, Bt) do { __builtin_amdgcn_s_setprio(1); _Pragma("unroll") for (int m = 0; m < 4; ++m) _Pragma("unroll") for (int n = 0; n < 2; ++n) _Pragma("unroll") for (int k = 0; k < 2; ++k) \
        acc[ai][bj][m][n] = __builtin_amdgcn_mfma_f32_16x16x32_bf16(Bt[n][k], At[m][k], acc[ai][bj][m][n], 0, 0, 0); __builtin_amdgcn_s_setprio(0); } while (0)
#define PG8_WAIT_V(n) asm volatile("s_waitcnt vmcnt(" #n ")" ::: "memory")
#define PG8_WAIT_L(n) asm volatile("s_waitcnt lgkmcnt(" #n ")" ::: "memory")
#define PG8_BAR __builtin_amdgcn_s_barrier()
#define PG8_SCHED __builtin_amdgcn_sched_barrier(0)
    Unit cur, nxt; int ui = 0;
    if (!S.next(0, cur)) return;
    f32x4 acc[2][2][4][2];
#pragma unroll
    for (int a = 0; a < 2; ++a)
#pragma unroll
        for (int b = 0; b < 2; ++b)
#pragma unroll
            for (int m = 0; m < 4; ++m)
#pragma unroll
                for (int n = 0; n < 2; ++n) acc[a][b][m][n] = (f32x4){0.f, 0.f, 0.f, 0.f};
    bf16x8 At[4][2], B0[2][2], B1[2][2];
    const char* cA = cur.A; const char* cB = cur.B;
    if constexpr (SP2) {
        PG8_STAGE(PG8_SB(0, 0), cB, voffB); PG8_STAGE(PG8_SB(0, 1), cB + hstepB, voffB); PG8_STAGE(PG8_SA(0, 0), cA, voffA); PG8_STAGE(PG8_SA(0, 1), cA + hstepA, voffA);
        if (wr == 1) PG8_BAR;
        PG8_WAIT_V(2); PG8_BAR;
        PG8_STAGE(PG8_SB(1, 0), cB + kstep, voffB); PG8_STAGE(PG8_SA(1, 0), cA + kstep, voffA); PG8_STAGE(PG8_SB(1, 1), cB + hstepB + kstep, voffB);
        PG8_WAIT_V(6); PG8_BAR;
    } else {
        PG8_STAGE(PG8_SB(0, 0), cB, voffB); PG8_STAGE(PG8_SA(0, 0), cA, voffA); PG8_STAGE(PG8_SB(0, 1), cB + hstepB, voffB); PG8_STAGE(PG8_SA(0, 1), cA + hstepA, voffA);
        if (wr == 1) PG8_BAR;
        PG8_WAIT_V(4); PG8_BAR;
        PG8_STAGE(PG8_SB(1, 0), cB + kstep, voffB); PG8_STAGE(PG8_SA(1, 0), cA + kstep, voffA); PG8_STAGE(PG8_SB(1, 1), cB + hstepB + kstep, voffB);
        PG8_WAIT_V(6); PG8_BAR;
    }
    for (;;) {
        const bool has_next = S.next(ui + 1, nxt);
        const int nt = cur.nt;
        const char* nA = has_next ? nxt.A : cA; const char* nB = has_next ? nxt.B : cB;
        for (int t = 0; t < nt; t += 2) {
            const bool last = (t == nt - 2);
            const char* a1 = cA + (size_t)(t + 1) * kstep;
            const char* a2 = last ? nA : cA + (size_t)(t + 2) * kstep; const char* b2 = last ? nB : cB + (size_t)(t + 2) * kstep;
            const char* a3 = a2 + kstep; const char* b3 = b2 + kstep;
            if constexpr (SP2) {
            PG8_LDB(B0, 0, 0); PG8_LDB(B1, 0, 1); PG8_SCHED; PG8_LDA(At, 0, 0); PG8_STAGE(PG8_SA(1, 1), a1 + hstepA, voffA);
            PG8_WAIT_V(8); PG8_WAIT_L(0); PG8_BAR; PG8_MMA(0, 0, At, B0); PG8_MMA(0, 1, At, B1); PG8_BAR; PG8_SCHED;
            PG8_LDA(At, 0, 1); PG8_STAGE(PG8_SB(0, 0), b2, voffB); PG8_STAGE(PG8_SB(0, 1), b2 + hstepB, voffB); PG8_STAGE(PG8_SA(0, 0), a2, voffA);
            PG8_WAIT_V(8); PG8_WAIT_L(0); PG8_BAR; PG8_MMA(1, 0, At, B0); PG8_MMA(1, 1, At, B1); PG8_BAR; PG8_SCHED;
            PG8_LDB(B0, 1, 0); PG8_LDB(B1, 1, 1); PG8_SCHED; PG8_LDA(At, 1, 0); PG8_STAGE(PG8_SA(0, 1), a2 + hstepA, voffA);
            PG8_WAIT_V(8); PG8_WAIT_L(0); PG8_BAR; PG8_MMA(0, 0, At, B0); PG8_MMA(0, 1, At, B1); PG8_BAR; PG8_SCHED;
            PG8_LDA(At, 1, 1); PG8_STAGE(PG8_SB(1, 0), b3, voffB); PG8_STAGE(PG8_SB(1, 1), b3 + hstepB, voffB); PG8_STAGE(PG8_SA(1, 0), a3, voffA);
            PG8_WAIT_V(8); PG8_WAIT_L(0); PG8_BAR; PG8_MMA(1, 0, At, B0); PG8_MMA(1, 1, At, B1); PG8_BAR; PG8_SCHED;
            } else {
            PG8_LDB(B0, 0, 0); PG8_SCHED; PG8_LDA(At, 0, 0); PG8_STAGE(PG8_SA(1, 1), a1 + hstepA, voffA);
            PG8_WAIT_L(8); PG8_BAR; PG8_WAIT_L(0); PG8_MMA(0, 0, At, B0); PG8_BAR; PG8_SCHED;
            PG8_LDB(B1, 0, 1); PG8_STAGE(PG8_SB(0, 0), b2, voffB);
            PG8_BAR; PG8_WAIT_L(0); PG8_MMA(0, 1, At, B1); PG8_BAR;
            PG8_LDA(At, 0, 1); PG8_STAGE(PG8_SA(0, 0), a2, voffA);
            PG8_BAR; PG8_WAIT_L(0); PG8_MMA(1, 0, At, B0); PG8_BAR; PG8_SCHED;
            PG8_STAGE(PG8_SB(0, 1), b2 + hstepB, voffB);
            PG8_WAIT_V(6); PG8_BAR; PG8_MMA(1, 1, At, B1); PG8_BAR;
            PG8_LDB(B0, 1, 0); PG8_SCHED; PG8_LDA(At, 1, 0); PG8_STAGE(PG8_SA(0, 1), a2 + hstepA, voffA);
            PG8_WAIT_L(8); PG8_BAR; PG8_WAIT_L(0); PG8_MMA(0, 0, At, B0); PG8_BAR; PG8_SCHED;
            PG8_LDB(B1, 1, 1); PG8_STAGE(PG8_SB(1, 0), b3, voffB);
            PG8_BAR; PG8_WAIT_L(0); PG8_MMA(0, 1, At, B1); PG8_BAR;
            PG8_LDA(At, 1, 1); PG8_STAGE(PG8_SA(1, 0), a3, voffA);
            PG8_BAR; PG8_WAIT_L(0); PG8_MMA(1, 0, At, B0); PG8_BAR; PG8_SCHED;
            PG8_STAGE(PG8_SB(1, 1), b3 + hstepB, voffB);
            PG8_WAIT_V(6); PG8_BAR; PG8_MMA(1, 1, At, B1); PG8_BAR;
            }
        }
        if constexpr (ALIGN_EPI) { if (wr == 0) PG8_BAR; }
        E(acc, cur, wr, wc, fr, fq);
        if (!has_next) break;
#pragma unroll
        for (int a = 0; a < 2; ++a)
#pragma unroll
            for (int b = 0; b < 2; ++b)
#pragma unroll
                for (int m = 0; m < 4; ++m)
#pragma unroll
                    for (int n = 0; n < 2; ++n) acc[a][b][m][n] = (f32x4){0.f, 0.f, 0.f, 0.f};
        cur = nxt; cA = nA; cB = nB; ++ui;
        if constexpr (ALIGN_EPI) { if (wr == 1) PG8_BAR; }
    }
    PG8_WAIT_V(0);
    if constexpr (!ALIGN_EPI) { if (wr == 0) PG8_BAR; }
    PG8_BAR;
#undef PG8_SA
#undef PG8_SB
#undef PG8_STAGE
#undef PG8_LDA
#undef PG8_LDB
#undef PG8_MMA
#undef PG8_WAIT_V
#undef PG8_WAIT_L
#undef PG8_BAR
#undef PG8_SCHED
}
}

constexpr int NL = 4, DM = 2048, MTOK = 6144, MCTX = 4096, DIN_ = 6144, NGATE = 8192, NIG = 14336, DFF = 5632, NUP = 11264, KBR = 2560;
constexpr int N_ADA = 12288;
constexpr float EPS_ = 1e-6f;
constexpr size_t OUT_Y = 0, OUT_NK = (size_t)MTOK * DM, OUT_NV = OUT_NK + (size_t)16 * 4 * 256 * 1024;
constexpr size_t OUT_TOTAL = OUT_NV + (size_t)16 * 4 * 256 * 1024;

constexpr size_t al256(size_t x) { return (x + 255) & ~(size_t)255; }
constexpr size_t WS_CTL = 0, CTL_ZERO_BYTES = 1u << 20;
constexpr size_t WS_MOD = WS_CTL + CTL_ZERO_BYTES;
constexpr size_t WS_PARTMOD = al256(WS_MOD + (size_t)NL * 3 * N_ADA * 4);
constexpr size_t WS_LAM = al256(WS_PARTMOD + (size_t)NL * 32 * 3 * N_ADA * 4);
constexpr size_t WS_ROPE = al256(WS_LAM + 256);
constexpr size_t WS_TWC = al256(WS_ROPE + 64 * 32 * 2 * 4);
constexpr size_t WS_TW256 = al256(WS_TWC + 512 * 256 * 2);
constexpr size_t WS_TW1024 = al256(WS_TW256 + 256 * 512 * 2);
constexpr size_t WS_WIG = al256(WS_TW1024 + 1024 * 2048 * 2);
constexpr size_t SZ_WIG = (size_t)NIG * DM * 2;
constexpr size_t WS_WBR = al256(WS_WIG + NL * SZ_WIG);
constexpr size_t SZ_WBR = (size_t)DM * KBR * 2;
constexpr size_t WS_WO = al256(WS_WBR + NL * SZ_WBR);
constexpr size_t SZ_WO = (size_t)DM * DM * 2;
constexpr size_t WS_WUP = al256(WS_WO + NL * SZ_WO);
constexpr size_t SZ_WUP = (size_t)NUP * DM * 2;
constexpr size_t WS_WDN = al256(WS_WUP + NL * SZ_WUP);
constexpr size_t SZ_WDN = (size_t)DM * DFF * 2;
constexpr size_t WS_H = al256(WS_WDN + NL * SZ_WDN);
constexpr size_t WS_PROJ = al256(WS_H + (size_t)MTOK * DM * 2);
constexpr size_t WS_GATES = al256(WS_PROJ + (size_t)MTOK * DIN_ * 2);
constexpr size_t WS_KCTX = al256(WS_GATES + (size_t)MTOK * NGATE * 2);
constexpr size_t WS_VCTX = al256(WS_KCTX + (size_t)MCTX * 1024 * 2);
constexpr size_t WS_KLAT = al256(WS_VCTX + (size_t)MCTX * 1024 * 2);
constexpr size_t SZ_KLAT = (size_t)2 * 1536 * 1024 * 2;
constexpr size_t WS_VLAT = al256(WS_KLAT + NL * SZ_KLAT);
constexpr size_t WS_AO = al256(WS_VLAT + NL * SZ_KLAT);
constexpr size_t WS_ML = al256(WS_AO + (size_t)2 * MTOK * 2048 * 4);
constexpr size_t WS_BR = al256(WS_ML + (size_t)2 * MTOK * 32 * 4);
constexpr size_t WS_PQC = al256(WS_BR + (size_t)MTOK * KBR * 2);
constexpr size_t WS_PQL = al256(WS_PQC + (size_t)16 * 512 * 512 * 2);
constexpr size_t WS_PART = al256(WS_PQL + (size_t)2 * 512 * 2048 * 2);
constexpr size_t WS_MERGED = al256(WS_PART + (size_t)3 * 192 * 32 * 512 * 16);
constexpr size_t WS_MIX = al256(WS_MERGED + (size_t)MTOK * DM * 2);
constexpr size_t WS_SSQ = al256(WS_MIX + (size_t)MTOK * DM * 4);
constexpr size_t WS_FACT = al256(WS_SSQ + (size_t)MTOK * 32 * 4);
constexpr size_t WS_END = al256(WS_FACT + (size_t)MTOK * DFF * 2);

constexpr int CW_BAR = 4096;

constexpr int RING_BYTES = 131072;
constexpr int LDSCTL_OFF = RING_BYTES, MISC_OFF = LDSCTL_OFF + 320;
constexpr int LDS_BYTES = 147456;

namespace pg8 {
struct EpiG1 {
    static constexpr bool PERM = true;
    bf16_t* proj; bf16_t* gates; bf16_t* kctx; bf16_t* vctx; bf16_t* klat; bf16_t* vlat; float* newk; float* newv; const float* bgate;
    __device__ __forceinline__ void operator()(const f32x4 (&acc)[2][2][4][2], const Unit& u, int wr, int wc, int fr, int fq) const {
        const int pm = u.pm, pn = u.pn, rl0 = wr * 64 + fr, cl0 = wc * 32 + 8 * fq;
        if (pn >= 24) {
            const int gc0 = (pn - 24) * 256 + cl0;
            f32x4 bv[2][2];
#pragma unroll
            for (int bj = 0; bj < 2; ++bj)
#pragma unroll
                for (int n = 0; n < 2; ++n) bv[bj][n] = *(const f32x4*)(bgate + gc0 + bj * HALF + 4 * n);
#pragma unroll
            for (int ai = 0; ai < 2; ++ai)
#pragma unroll
                for (int m = 0; m < 4; ++m) { bf16_t* rowp = gates + (size_t)(pm * 256 + ai * HALF + m * 16 + rl0) * NGATE + gc0;
#pragma unroll
                    for (int bj = 0; bj < 2; ++bj) { const f32x4 v0 = acc[ai][bj][m][0] + bv[bj][0], v1 = acc[ai][bj][m][1] + bv[bj][1];
                        u32x4 w; w.x = cvt_pk_bf16(sigmoid_f(v0[0]), sigmoid_f(v0[1])); w.y = cvt_pk_bf16(sigmoid_f(v0[2]), sigmoid_f(v0[3]));
                        w.z = cvt_pk_bf16(sigmoid_f(v1[0]), sigmoid_f(v1[1])); w.w = cvt_pk_bf16(sigmoid_f(v1[2]), sigmoid_f(v1[3]));
                        *(u32x4*)(rowp + bj * HALF) = w; } }
        } else if (pn >= 8 && pn < 16) {
            const bool isv = pn >= 12; const int c0 = (pn - (isv ? 12 : 8)) * 256 + cl0;
            bf16_t* base; float* ob = nullptr;
            if (pm < 16) { base = (isv ? vctx : kctx) + (size_t)(pm * 256) * 1024; ob = (isv ? newv : newk) + (size_t)(pm * 4) * 256 * 1024; }
            else { const int b = (pm - 16) >> 2, lr = ((pm - 16) & 3) * 256; base = (isv ? vlat : klat) + (size_t)(b * 1536 + 512 + lr) * 1024; }
#pragma unroll
            for (int ai = 0; ai < 2; ++ai)
#pragma unroll
                for (int m = 0; m < 4; ++m) { const size_t ro = (size_t)(ai * HALF + m * 16 + rl0) * 1024 + c0;
#pragma unroll
                    for (int bj = 0; bj < 2; ++bj) { const f32x4 v0 = acc[ai][bj][m][0], v1 = acc[ai][bj][m][1];
                        u32x4 w; w.x = cvt_pk_bf16(v0[0], v0[1]); w.y = cvt_pk_bf16(v0[2], v0[3]); w.z = cvt_pk_bf16(v1[0], v1[1]); w.w = cvt_pk_bf16(v1[2], v1[3]);
                        *(u32x4*)(base + ro + bj * HALF) = w;
                        if (ob) { *(f32x4*)(ob + ro + bj * HALF) = v0; *(f32x4*)(ob + ro + bj * HALF + 4) = v1; } } }
        } else {
#pragma unroll
            for (int ai = 0; ai < 2; ++ai)
#pragma unroll
                for (int m = 0; m < 4; ++m) { bf16_t* rowp = proj + (size_t)(pm * 256 + ai * HALF + m * 16 + rl0) * DIN_ + pn * 256 + cl0;
#pragma unroll
                    for (int bj = 0; bj < 2; ++bj) { const f32x4 v0 = acc[ai][bj][m][0], v1 = acc[ai][bj][m][1];
                        u32x4 w; w.x = cvt_pk_bf16(v0[0], v0[1]); w.y = cvt_pk_bf16(v0[2], v0[3]); w.z = cvt_pk_bf16(v1[0], v1[1]); w.w = cvt_pk_bf16(v1[2], v1[3]);
                        *(u32x4*)(rowp + bj * HALF) = w; } }
        }
    }
};
struct EpiBf16 {
    static constexpr bool PERM = true;
    bf16_t* O; int ldc; int coloff;
    __device__ __forceinline__ void operator()(const f32x4 (&acc)[2][2][4][2], const Unit& u, int wr, int wc, int fr, int fq) const {
#pragma unroll
        for (int ai = 0; ai < 2; ++ai)
#pragma unroll
            for (int m = 0; m < 4; ++m) { bf16_t* rowp = O + (size_t)(u.pm * 256 + ai * HALF + m * 16 + wr * 64 + fr) * ldc + coloff + u.pn * 256 + wc * 32 + 8 * fq;
#pragma unroll
                for (int bj = 0; bj < 2; ++bj) { const f32x4 v0 = acc[ai][bj][m][0], v1 = acc[ai][bj][m][1];
                    u32x4 w; w.x = cvt_pk_bf16(v0[0], v0[1]); w.y = cvt_pk_bf16(v0[2], v0[3]); w.z = cvt_pk_bf16(v1[0], v1[1]); w.w = cvt_pk_bf16(v1[2], v1[3]);
                    *(u32x4*)(rowp + bj * HALF) = w; } }
    }
};
struct EpiF1 {
    static constexpr bool PERM = true;
    bf16_t* pqc; bf16_t* pql;
    __device__ __forceinline__ void operator()(const f32x4 (&acc)[2][2][4][2], const Unit& u, int wr, int wc, int fr, int fq) const {
        const int g = 2 * u.aux + u.pm, pn = u.pn; bf16_t* base; int T, tl0;
        if (pn < 16) { base = pqc + (size_t)pn * 512 * 512; T = 256; tl0 = 0; } else { base = pql + (size_t)((pn - 16) >> 2) * 512 * 2048; T = 1024; tl0 = ((pn - 16) & 3) * 256; }
#pragma unroll
        for (int ai = 0; ai < 2; ++ai)
#pragma unroll
            for (int m = 0; m < 4; ++m) { const int j = wr * 64 + m * 16 + fr; bf16_t* rowp = base + (size_t)(g * 128 + j) * (2 * T) + ai * T + tl0 + wc * 32 + 8 * fq;
#pragma unroll
                for (int bj = 0; bj < 2; ++bj) { const f32x4 v0 = acc[ai][bj][m][0], v1 = acc[ai][bj][m][1];
                    u32x4 w; w.x = cvt_pk_bf16(v0[0], v0[1]); w.y = cvt_pk_bf16(v0[2], v0[3]); w.z = cvt_pk_bf16(v1[0], v1[1]); w.w = cvt_pk_bf16(v1[2], v1[3]);
                    *(u32x4*)(rowp + bj * HALF) = w; } }
    }
};
struct EpiG2 {
    static constexpr bool PERM = false;
    const bf16_t* gates; float* part; bf16_t* merged;
    static constexpr size_t SLAB = (size_t)192 * 32 * 512 * 4;
    __device__ __forceinline__ void operator()(const f32x4 (&acc)[2][2][4][2], const Unit& u, int wr, int wc, int fr, int fq) const {
        const int i = u.aux, tile = u.pm * 8 + u.pn, tid = (wr * 4 + wc) * 64 + fq * 16 + fr;
        float* pb = part + ((size_t)tile * 32 * 512 + tid) * 4;
#pragma unroll
        for (int ai = 0; ai < 2; ++ai)
#pragma unroll
            for (int m = 0; m < 4; ++m) { const size_t row = (size_t)(u.pm * 256 + ai * HALF + m * 16 + wr * 64 + fr);
                const bf16_t* gp = gates + row * NGATE + i * 2048 + u.pn * 256 + wc * 32 + 4 * fq;
                u32x2 gw[2][2];
#pragma unroll
                for (int bj = 0; bj < 2; ++bj)
#pragma unroll
                    for (int n = 0; n < 2; ++n) gw[bj][n] = *(const u32x2*)(gp + bj * HALF + n * 16);
#pragma unroll
                for (int bj = 0; bj < 2; ++bj)
#pragma unroll
                    for (int n = 0; n < 2; ++n) { const int col = u.pn * 256 + bj * HALF + wc * 32 + n * 16 + 4 * fq;
                        f32x4 v = acc[ai][bj][m][n]; v[0] *= bf_lo(gw[bj][n].x); v[1] *= bf_hi(gw[bj][n].x); v[2] *= bf_lo(gw[bj][n].y); v[3] *= bf_hi(gw[bj][n].y);
                        float* p = pb + (size_t)((((ai * 4 + m) * 2 + bj) * 2 + n) * 512) * 4;
                        if (i < 3) *(f32x4*)(p + (size_t)i * SLAB) = v;
                        else { const f32x4 p0 = *(const f32x4*)p, p1 = *(const f32x4*)(p + SLAB), p2 = *(const f32x4*)(p + 2 * SLAB); v = ((p0 + p1) + p2) + v;
                            u32x2 w; w.x = cvt_pk_bf16(v[0], v[1]); w.y = cvt_pk_bf16(v[2], v[3]); *(u32x2*)(merged + row * DM + col) = w; } } }
    }
};
struct EpiSsq {
    static constexpr bool PERM = false;
    float* out; float* ssq;
    __device__ __forceinline__ void operator()(const f32x4 (&acc)[2][2][4][2], const Unit& u, int wr, int wc, int fr, int fq) const {
#pragma unroll
        for (int ai = 0; ai < 2; ++ai)
#pragma unroll
            for (int m = 0; m < 4; ++m) { const size_t row = (size_t)(u.pm * 256 + ai * HALF + m * 16 + wr * 64 + fr); float s = 0.f;
#pragma unroll
                for (int bj = 0; bj < 2; ++bj)
#pragma unroll
                    for (int n = 0; n < 2; ++n) { const int col = u.pn * 256 + bj * HALF + wc * 32 + n * 16 + 4 * fq; const f32x4 v = acc[ai][bj][m][n];
                        *(f32x4*)(out + row * DM + col) = v; s += (v[0] * v[0] + v[1] * v[1]) + (v[2] * v[2] + v[3] * v[3]); }
                s += __shfl_xor(s, 16); s += __shfl_xor(s, 32);
                if (fq == 0) ssq[((size_t)u.pn * MTOK + row) * 4 + wc] = s; }
    }
};
struct EpiSwiGLU {
    static constexpr bool PERM = false;
    bf16_t* fact;
    __device__ __forceinline__ void operator()(const f32x4 (&acc)[2][2][4][2], const Unit& u, int wr, int wc, int fr, int fq) const {
#pragma unroll
        for (int ai = 0; ai < 2; ++ai)
#pragma unroll
            for (int m = 0; m < 4; ++m) { const size_t row = (size_t)(u.pm * 256 + ai * HALF + m * 16 + wr * 64 + fr);
#pragma unroll
                for (int bj = 0; bj < 2; ++bj) { const f32x4 up = acc[ai][bj][m][0], gt = acc[ai][bj][m][1]; const int j = u.pn * 128 + (4 * bj + wc) * 16 + 4 * fq;
                    u32x2 w; w.x = cvt_pk_bf16(gt[0] * sigmoid_f(gt[0]) * up[0], gt[1] * sigmoid_f(gt[1]) * up[1]); w.y = cvt_pk_bf16(gt[2] * sigmoid_f(gt[2]) * up[2], gt[3] * sigmoid_f(gt[3]) * up[3]);
                    *(u32x2*)(fact + row * DFF + j) = w; } }
    }
};
struct SchedG2 {
    int G, c; const char* A; const char* B;
    __device__ __forceinline__ bool next(int i, Unit& u) const {
        int pm, pn; if (!tile_order((long)(i >> 2) * G + c, 24, 8, pm, pn)) return false;
        const int br = i & 3, koff = br == 0 ? 0 : (br == 1 ? 512 : (br == 2 ? 1536 : 2048));
        u.pm = pm; u.pn = pn; u.aux = br; u.nt = br == 1 ? 16 : 8;
        u.A = A + ((size_t)pm * 256 * KBR + koff) * 2; u.B = B + ((size_t)pn * 256 * KBR + koff) * 2; return true;
    }
};
struct SchedF1 {
    int G, c, nt; const char* A; const char* B;
    __device__ __forceinline__ bool next(int i, Unit& u) const {
        const int L = i * G + c; if (L >= 96) return false;
        const int p = L / 48, r = L % 48; u.pm = r & 1; u.pn = r >> 1; u.aux = p; u.nt = nt;
        u.A = A + (size_t)u.pm * 256 * 256 * 2; u.B = B + ((size_t)(u.pn * 256) * DIN_ + 5632 + p * 256) * 2; return true;
    }
};
struct SchedF2L {
    int c; const char* A; const char* B;
    __device__ __forceinline__ bool next(int i, Unit& u) const {
        if (i != 0 || c >= 16) return false;
        const int b = c >> 3, pm = (c >> 1) & 3, pn = c & 1; u.pm = 16 + b * 4 + pm; u.pn = pn; u.aux = 0; u.nt = 32;
        u.A = A + (size_t)pm * 256 * 2048 * 2; u.B = B + ((size_t)b * 512 * 2048 + (size_t)pn * 256 * 2048) * 2; return true;
    }
};
struct SchedF2C {
    int c; const char* A; const char* B;
    __device__ __forceinline__ bool next(int i, Unit& u) const {
        if (i != 0 || c < 16 || c >= 48) return false;
        const int idx = c - 16, s = idx >> 1, pn = idx & 1; u.pm = s; u.pn = pn; u.aux = 0; u.nt = 8;
        u.A = A; u.B = B + ((size_t)s * 512 * 512 + (size_t)pn * 256 * 512) * 2; return true;
    }
};
}

namespace att {
constexpr int D = 128, NW = 8, QBLK = 32, KVBLK = 64;
constexpr float SCALE = 0.088388347648318440f;
constexpr float THR = 8.f;
constexpr int LDQ = 6144, LDK = 1024, LDO = 2048;
constexpr size_t SHM_V = KVBLK * D * 2, SHM_K = KVBLK * D * 2, SHM_ATTN = 2 * SHM_V + 2 * SHM_K + NW * 64 * 4;
#define KSWZ(row, colB) ((row) * 256 + ((colB) ^ (((row) & 7) << 4)))
#define SBAR() __builtin_amdgcn_sched_barrier(0)
__device__ __forceinline__ int crow(int r, int hi) { return (r & 3) + 8 * (r >> 2) + 4 * hi; }
__device__ __forceinline__ unsigned cvtpk(float lo, float hi) { return cvt_pk_bf16_c(lo, hi); }

__device__ __forceinline__ void partialSM(f32x16& p0, f32x16& p1, float& m_reg, float& mn, float& alpha) {
  constexpr float C = SCALE * 1.4426950408889634f;
  float pmax = p0[0];
#pragma unroll
  for (int r = 1; r < 16; ++r) pmax = fmaxf(pmax, p0[r]);
#pragma unroll
  for (int r = 0; r < 16; ++r) pmax = fmaxf(pmax, p1[r]);
  { auto rr = __builtin_amdgcn_permlane32_swap(__float_as_uint(pmax), __float_as_uint(pmax), false, false);
    pmax = fmaxf(__uint_as_float(rr[0]), __uint_as_float(rr[1])); }
  if (__builtin_expect(__all(pmax - m_reg <= THR / SCALE), 1)) { mn = m_reg; alpha = 1.f; }
  else { mn = fmaxf(m_reg, pmax); alpha = __builtin_amdgcn_exp2f((m_reg - mn) * C); m_reg = mn; }
  float mnC = -mn * C;
#pragma unroll
  for (int r = 0; r < 16; ++r) p0[r] = fmaf(p0[r], C, mnC);
#pragma unroll
  for (int r = 0; r < 16; ++r) p1[r] = fmaf(p1[r], C, mnC);
#pragma unroll
  for (int r = 0; r < 16; ++r) p0[r] = __builtin_amdgcn_exp2f(p0[r]);
}
__device__ __forceinline__ void finishSM(f32x16& p0, f32x16& p1, float alpha, float& l_reg, bf16x8& pa0, bf16x8& pa1, bf16x8& pa2, bf16x8& pa3) {
#pragma unroll
  for (int r = 0; r < 16; ++r) p1[r] = __builtin_amdgcn_exp2f(p1[r]);
  float ps = 0;
#pragma unroll
  for (int r = 0; r < 16; ++r) ps += p0[r];
#pragma unroll
  for (int r = 0; r < 16; ++r) ps += p1[r];
  { auto rr = __builtin_amdgcn_permlane32_swap(__float_as_uint(ps), __float_as_uint(ps), false, false);
    ps = __uint_as_float(rr[0]) + __uint_as_float(rr[1]); }
  l_reg = l_reg * alpha + ps;
#define PK4(P, BASE, OUT) do { unsigned a0 = cvtpk(P[BASE + 0], P[BASE + 1]), a1 = cvtpk(P[BASE + 2], P[BASE + 3]);   \
    unsigned b0 = cvtpk(P[BASE + 4], P[BASE + 5]), b1 = cvtpk(P[BASE + 6], P[BASE + 7]);                              \
    auto r0 = __builtin_amdgcn_permlane32_swap(a0, b0, false, false); auto r1 = __builtin_amdgcn_permlane32_swap(a1, b1, false, false); \
    v4u w = {r0[0], r1[0], r0[1], r1[1]}; OUT = __builtin_bit_cast(bf16x8, w); } while (0)
  PK4(p0, 0, pa0); PK4(p0, 8, pa1); PK4(p1, 0, pa2); PK4(p1, 8, pa3);
#undef PK4
}
__device__ __forceinline__ void qkt(f32x16& p0, f32x16& p1, const LAS char* Ks, const bf16x8* qr, int r32, int hi) {
  p0 = f32x16{}; p1 = f32x16{};
#pragma unroll
  for (int d0 = 0; d0 < 8; ++d0) { int cb = (d0 * 16 + hi * 8) * 2;
    bf16x8 b0 = *(const LAS bf16x8*)(Ks + KSWZ(r32, cb));
    bf16x8 b1 = *(const LAS bf16x8*)(Ks + KSWZ(32 + r32, cb));
    p0 = __builtin_amdgcn_mfma_f32_32x32x16_bf16(b0, qr[d0], p0, 0, 0, 0);
    p1 = __builtin_amdgcn_mfma_f32_32x32x16_bf16(b1, qr[d0], p1, 0, 0, 0); }
}
__device__ __forceinline__ int v_st(int k, int c) { const int kk = (k & ~0xC) | ((k & 4) << 1) | ((k & 8) >> 1); return ((kk >> 3) * 4 + (c >> 5)) * 512 + ((kk & 7) * 32 + (c & 31)) * 2; }
__device__ __forceinline__ int v_rd_base(int lane) { return ((lane & 3) << 3) | (((lane >> 2) & 3) << 6) | (((lane >> 4) & 1) << 5) | (((lane >> 5) & 1) << 8); }
constexpr int v_rd_off(int d0, int ks, int half) { return d0 * 512 + ks * 4096 + half * 2048; }
template <int OFF> __device__ __forceinline__ s16x4 tr_read(int vb) {
  s16x4 r; asm volatile("ds_read_b64_tr_b16 %0, %1 offset:%2" : "=&v"(r) : "v"(vb), "i"(OFF) : "memory"); return r;
}
template <int D0> __device__ __forceinline__ void pv_one(f32x16& od, int vb, bf16x8 pa0, bf16x8 pa1, bf16x8 pa2, bf16x8 pa3) {
  const s16x4 l0 = tr_read<v_rd_off(D0, 0, 0)>(vb), h0 = tr_read<v_rd_off(D0, 0, 1)>(vb), l1 = tr_read<v_rd_off(D0, 1, 0)>(vb), h1 = tr_read<v_rd_off(D0, 1, 1)>(vb);
  const s16x4 l2 = tr_read<v_rd_off(D0, 2, 0)>(vb), h2 = tr_read<v_rd_off(D0, 2, 1)>(vb), l3 = tr_read<v_rd_off(D0, 3, 0)>(vb), h3 = tr_read<v_rd_off(D0, 3, 1)>(vb);
  asm volatile("s_waitcnt lgkmcnt(0)" ::: "memory"); SBAR();
#define PK(L, H) (bf16x8){L[0], L[1], L[2], L[3], H[0], H[1], H[2], H[3]}
  od = __builtin_amdgcn_mfma_f32_32x32x16_bf16(pa0, PK(l0, h0), od, 0, 0, 0);
  od = __builtin_amdgcn_mfma_f32_32x32x16_bf16(pa1, PK(l1, h1), od, 0, 0, 0);
  od = __builtin_amdgcn_mfma_f32_32x32x16_bf16(pa2, PK(l2, h2), od, 0, 0, 0);
  od = __builtin_amdgcn_mfma_f32_32x32x16_bf16(pa3, PK(l3, h3), od, 0, 0, 0);
#undef PK
}
__device__ __forceinline__ void pv_d0(f32x16* o, int vb, bf16x8 pa0, bf16x8 pa1, bf16x8 pa2, bf16x8 pa3) {
  pv_one<0>(o[0], vb, pa0, pa1, pa2, pa3); pv_one<1>(o[1], vb, pa0, pa1, pa2, pa3); pv_one<2>(o[2], vb, pa0, pa1, pa2, pa3); pv_one<3>(o[3], vb, pa0, pa1, pa2, pa3);
}

__device__ __forceinline__ void attn_unit(const bf16* __restrict__ Qb, const bf16* __restrict__ Kh, const bf16* __restrict__ Vh,
                                          float* __restrict__ Ob, float* __restrict__ MLb, int seq, LAS char* lds, const int tid) {
  const int wid = tid >> 6, lane = tid & 63, r32 = lane & 31, hi = lane >> 5;
  LAS char* V_lds = lds; LAS char* K_lds = lds + 2 * SHM_V;
  LAS float* wsf = (LAS float*)(lds + 2 * SHM_V + 2 * SHM_K) + wid * 64; LAS float* al_l = wsf + 32;
  float m_reg = -1e30f, l_reg = 0; f32x16 o[4] = {}; bf16x8 qr[8];
  const int qoff = (wid * QBLK + r32) * LDQ + hi * 8;
#pragma unroll
  for (int d0 = 0; d0 < 8; ++d0) qr[d0] = *(const bf16x8*)(Qb + qoff + d0 * 16);
  const int sr = tid >> 4, sc = (tid & 15) * 8, vst0 = v_st(sr, sc), vst1 = v_st(32 + sr, sc);
  const int vb0 = (int)(unsigned)(uintptr_t)V_lds + v_rd_base(lane);
  const int kvoff = sr * LDK + sc;
  struct { bf16x8 vs0, vs1, ks0, ks1; } sr_[2];
#define SLOAD(i, k0) do { const bf16* Vt_ = Vh + (size_t)(k0) * LDK; const bf16* Kt_ = Kh + (size_t)(k0) * LDK; \
    sr_[i].vs0 = *(const bf16x8*)(Vt_ + kvoff); sr_[i].vs1 = *(const bf16x8*)(Vt_ + 32 * LDK + kvoff); \
    sr_[i].ks0 = *(const bf16x8*)(Kt_ + kvoff); sr_[i].ks1 = *(const bf16x8*)(Kt_ + 32 * LDK + kvoff); } while (0)
#define SWRITE(b, i) do { *(LAS bf16x8*)(V_lds + (b) * SHM_V + vst0) = sr_[i].vs0;          \
    *(LAS bf16x8*)(V_lds + (b) * SHM_V + vst1) = sr_[i].vs1; int kc = sc * 2;               \
    *(LAS bf16x8*)(K_lds + (b) * SHM_K + KSWZ(sr, kc)) = sr_[i].ks0;                       \
    *(LAS bf16x8*)(K_lds + (b) * SHM_K + KSWZ(32 + sr, kc)) = sr_[i].ks1; } while (0)
#define SWAIT() asm volatile("s_waitcnt vmcnt(4)" ::: "memory")
#define RESC(a) do { if (__any((a) < 1.f)) { if (hi == 0) al_l[r32] = (a); asm volatile("s_waitcnt lgkmcnt(0)" ::: "memory"); \
    _Pragma("unroll") for (int d = 0; d < 4; ++d) _Pragma("unroll") for (int r = 0; r < 16; ++r) o[d][r] *= al_l[crow(r, hi)]; } } while (0)
  f32x16 pA0, pA1, pB0, pB1; float mnA, mnB, alA, alB; bf16x8 pa0, pa1, pa2, pa3; const int NT = seq / KVBLK;
  constexpr int SE = 0, SO = 1;
  SLOAD(SE, 0); asm volatile("s_waitcnt vmcnt(0)" ::: "memory"); SWRITE(0, SE); __syncthreads();
  qkt(pA0, pA1, K_lds, qr, r32, hi); partialSM(pA0, pA1, m_reg, mnA, alA);
  SLOAD(SO, KVBLK); if (2 < NT) SLOAD(SE, 2 * KVBLK);
  SWAIT(); SWRITE(1, SO); __syncthreads();
  for (int j = 1; j + 1 < NT; j += 2) {
    SBAR(); qkt(pB0, pB1, K_lds + SHM_K, qr, r32, hi);
    finishSM(pA0, pA1, alA, l_reg, pa0, pa1, pa2, pa3); SBAR();
    SLOAD(SO, (j + 2) * KVBLK); SBAR();
    pv_d0(o, vb0, pa0, pa1, pa2, pa3); partialSM(pB0, pB1, m_reg, mnB, alB);
    __syncthreads(); SWAIT(); SWRITE(0, SE);
    RESC(alB); __syncthreads();
    SBAR(); qkt(pA0, pA1, K_lds, qr, r32, hi);
    finishSM(pB0, pB1, alB, l_reg, pa0, pa1, pa2, pa3); SBAR();
    if (j + 3 < NT) SLOAD(SE, (j + 3) * KVBLK); SBAR();
    pv_d0(o, vb0 + (int)SHM_V, pa0, pa1, pa2, pa3); partialSM(pA0, pA1, m_reg, mnA, alA);
    __syncthreads(); SWAIT(); SWRITE(1, SO);
    RESC(alA); __syncthreads();
  }
  SBAR(); qkt(pB0, pB1, K_lds + SHM_K, qr, r32, hi);
  finishSM(pA0, pA1, alA, l_reg, pa0, pa1, pa2, pa3); SBAR();
  pv_d0(o, vb0, pa0, pa1, pa2, pa3); partialSM(pB0, pB1, m_reg, mnB, alB);
  __syncthreads(); RESC(alB);
  finishSM(pB0, pB1, alB, l_reg, pa0, pa1, pa2, pa3); SBAR();
  pv_d0(o, vb0 + (int)SHM_V, pa0, pa1, pa2, pa3);
  const int ooff = (wid * QBLK + 4 * hi) * LDO + r32;
#pragma unroll
  for (int r = 0; r < 16; ++r) {
#pragma unroll
    for (int d0 = 0; d0 < 4; ++d0) Ob[ooff + ((r & 3) + 8 * (r >> 2)) * LDO + d0 * 32] = o[d0][r]; }
  if (hi == 0) { const int mo = (wid * QBLK + r32) * 2; MLb[mo] = m_reg; MLb[mo + 1] = l_reg; }
  __syncthreads();
#undef SLOAD
#undef SWRITE
#undef SWAIT
#undef RESC
}
#undef KSWZ
#undef SBAR
}
#define XB_TMO      128
#define XB_XCNT(j)  (256  + 64 * (j))
#define XB_XSUB(j)  (1280 + 64 * (j))
#define XB_XGEN(j)  (2304 + 64 * (j))
#define XB_TOP      3328
#define XB_TOPGEN   3392
#define XCD_BAR_WORDS 3456
#define XB_SPIN_CAP (1u << 18)

__device__ __forceinline__ unsigned xb_ld(unsigned* p)              { return __hip_atomic_load(p, __ATOMIC_RELAXED, __HIP_MEMORY_SCOPE_AGENT); }
__device__ __forceinline__ unsigned xb_add(unsigned* p, unsigned v) { return __hip_atomic_fetch_add(p, v, __ATOMIC_RELAXED, __HIP_MEMORY_SCOPE_AGENT); }
__device__ __forceinline__ unsigned xb_xcc_id() { return (unsigned)__builtin_amdgcn_s_getreg((3 << 11) | 20) & 0xFu; }
#define XB_SPIN(cond, bar) do { unsigned _sp = 0; while (cond) { __builtin_amdgcn_s_sleep(1); \
    if ((++_sp & 255u) == 0u) { if (xb_ld(&(bar)[XB_TMO])) break; if (_sp > XB_SPIN_CAP) { atomicAdd(&(bar)[XB_TMO], 1u); break; } } } } while (0)

struct XcdBarrier {
    unsigned* bar; unsigned x;
    volatile LAS unsigned* st;
};

__device__ __forceinline__ XcdBarrier xcd_barrier_post(unsigned* bar, volatile LAS unsigned* st) {
    XcdBarrier b; b.bar = bar; b.x = xb_xcc_id(); b.st = st;
    if (threadIdx.x == 0) (void)xb_add(&bar[XB_XCNT(b.x)], 1u);
    return b;
}
__device__ __forceinline__ void xcd_barrier_complete(unsigned* bar, unsigned x, unsigned& nloc, unsigned& nx) {
    const unsigned G = gridDim.x * gridDim.y * gridDim.z;
    unsigned sum, cnt, mine, sp = 0u;
    for (;;) {
        sum = 0u; cnt = 0u; mine = 0u;
#pragma unroll
        for (unsigned j = 0; j < 16; ++j) { const unsigned c = xb_ld(&bar[XB_XCNT(j)]); sum += c; cnt += (c > 0u) ? 1u : 0u; mine = (j == x) ? c : mine; }
        if (sum == G) break;
        __builtin_amdgcn_s_sleep(1);
        if ((++sp & 255u) == 0u) { if (xb_ld(&bar[XB_TMO])) break; if (sp > XB_SPIN_CAP) { atomicAdd(&bar[XB_TMO], 1u); break; } }
    }
    nloc = mine > 0u ? mine : 1u; nx = cnt > 0u ? cnt : 1u;
}

__device__ __forceinline__ void xcd_barrier(const XcdBarrier& b) {
    asm volatile("s_waitcnt vmcnt(0)" ::: "memory");
    __syncthreads();
    if (threadIdx.x == 0) {
        unsigned* bar = b.bar;
        __builtin_amdgcn_s_waitcnt(0);
        unsigned nloc = b.st[0], nx = b.st[1];
        if (nloc == 0u) { xcd_barrier_complete(bar, b.x, nloc, nx); b.st[0] = nloc; b.st[1] = nx; }
        const unsigned old = xb_add(&bar[XB_XSUB(b.x)], 1u);
        const unsigned gen = old / nloc;
        if (old + 1u == (gen + 1u) * nloc) {
            __builtin_amdgcn_fence(__ATOMIC_RELEASE, "agent");
            asm volatile("s_waitcnt vmcnt(0)" ::: "memory");
            const unsigned og = xb_add(&bar[XB_TOP], 1u);
            const unsigned tg = og / nx;
            if (og + 1u == (tg + 1u) * nx) xb_add(&bar[XB_TOPGEN], 1u);
            else XB_SPIN(xb_ld(&bar[XB_TOPGEN]) == tg, bar);
            __builtin_amdgcn_fence(__ATOMIC_ACQUIRE, "agent");
            xb_add(&bar[XB_XGEN(b.x)], 1u);
            asm volatile("s_waitcnt vmcnt(0)" ::: "memory");
        } else {
            XB_SPIN(xb_ld(&bar[XB_XGEN(b.x)]) == gen, bar);
            __builtin_amdgcn_fence(__ATOMIC_ACQUIRE, "agent");
            asm volatile("s_waitcnt vmcnt(0)" ::: "memory");
        }
    }
    __syncthreads();
}

struct Params { const float* in[32]; float* out; unsigned char* ws; };

__device__ __forceinline__ void transpose_item(const float* W, int N, bf16* WT, int ldw, int koff, int rowoff, int upmode, LAS float* scr, int item, int lane) {
    const int nblk = N / 32, kb = item / nblk, nb = item % nblk, k0 = 64 * kb, n0 = 32 * nb;
#pragma unroll 8
    for (int i = 0; i < 32; ++i) { const int kk = 2 * i + (lane >> 5); scr[kk * 33 + (lane & 31)] = W[(size_t)(k0 + kk) * N + n0 + (lane & 31)]; }
    LDS_WAIT(); asm volatile("" ::: "memory");
    const int c = lane & 7;
#pragma unroll
    for (int j = 0; j < 4; ++j) { const int n = (lane >> 3) + 8 * j; const LAS float* s = scr + (8 * c) * 33 + n;
        v4u o; o.x = pk2(s[0 * 33], s[1 * 33]); o.y = pk2(s[2 * 33], s[3 * 33]); o.z = pk2(s[4 * 33], s[5 * 33]); o.w = pk2(s[6 * 33], s[7 * 33]);
        const int nn = n0 + n; int row;
        if (upmode) { const int isgt = nn >= DFF ? 1 : 0; const int jj = nn - isgt * DFF; row = (jj >> 7) * 256 + ((jj & 127) >> 4) * 32 + isgt * 16 + (jj & 15); }
        else row = rowoff + nn;
        *(GAS v4u*)(WT + (size_t)row * ldw + koff + k0 + 8 * c) = o; }
    LDS_WAIT(); asm volatile("" ::: "memory");
}

template <bool HAS_ADD>
__device__ __forceinline__ void row_phase(int gw, int NGW, int lane, const float* xin_ctx, const float* xin_lat, float* X, const float* add, const float* ssq,
                                          const float* modg, const float* gpost, bool has_norm, const float* gnext, const float* modsc, const float* modsh, bf16* H) {
    for (int row = gw; row < MTOK; row += NGW) {
        const int v = row < MCTX ? 0 : 1 + ((row - MCTX) >> 10);
        const float* xr = row < MCTX ? xin_ctx + (size_t)row * DM : xin_lat + (size_t)(row - MCTX) * DM;
        f32x4 x[8];
#pragma unroll
        for (int j = 0; j < 8; ++j) x[j] = *(const f32x4*)(xr + 4 * lane + 256 * j);
        if constexpr (HAS_ADD) {
            float sp = lane < 32 ? ssq[((size_t)(lane >> 2) * MTOK + row) * 4 + (lane & 3)] : 0.f;
            const float rs = __builtin_amdgcn_rsqf(wave_sum(sp) * (1.0f / DM) + EPS_);
            const float* ar = add + (size_t)row * DM; const float* gv = modg + (size_t)v * N_ADA;
#pragma unroll
            for (int j = 0; j < 8; ++j) { const int col = 4 * lane + 256 * j; const f32x4 a = *(const f32x4*)(ar + col), g = *(const f32x4*)(gv + col), gp = *(const f32x4*)(gpost + col);
                x[j] = x[j] + g * (a * rs * gp); }
        }
        float* xo = X + (size_t)row * DM;
#pragma unroll
        for (int j = 0; j < 8; ++j) *(f32x4*)(xo + 4 * lane + 256 * j) = x[j];
        if (has_norm) {
            float s2 = 0.f;
#pragma unroll
            for (int j = 0; j < 8; ++j) s2 += (x[j][0] * x[j][0] + x[j][1] * x[j][1]) + (x[j][2] * x[j][2] + x[j][3] * x[j][3]);
            const float r2 = __builtin_amdgcn_rsqf(wave_sum(s2) * (1.0f / DM) + EPS_);
            const float* scv = modsc + (size_t)v * N_ADA; const float* shv = modsh + (size_t)v * N_ADA; bf16* ho = H + (size_t)row * DM;
#pragma unroll
            for (int j = 0; j < 8; ++j) { const int col = 4 * lane + 256 * j; const f32x4 gn = *(const f32x4*)(gnext + col), sc = *(const f32x4*)(scv + col), sh = *(const f32x4*)(shv + col);
                const f32x4 h = x[j] * r2 * gn * (sc + 1.0f) + sh; v2u w; w.x = pk2(h[0], h[1]); w.y = pk2(h[2], h[3]); *(v2u*)(ho + col) = w; }
        }
    }
}

constexpr int PTAB_OFF = LDSCTL_OFF + 1024;
__device__ __forceinline__ const float* ldptr(LAS const unsigned long long* t, int i) {
    const unsigned long long v = t[i]; const unsigned lo = __builtin_amdgcn_readfirstlane((unsigned)v), hi = __builtin_amdgcn_readfirstlane((unsigned)(v >> 32));
    return (const float*)(GAS const float*)(((unsigned long long)hi << 32) | lo);
}
__global__ void __launch_bounds__(512, 2) mk_fwd(Params p) {
    extern __shared__ __attribute__((aligned(16))) unsigned char lds_raw[];
    LAS unsigned char* lds = (LAS unsigned char*)lds_raw;
    volatile LAS unsigned* MISC = (volatile LAS unsigned*)(lds + MISC_OFF);
    const int wave_s = __builtin_amdgcn_readfirstlane(threadIdx.x >> 6);
    for (int u = threadIdx.x; u < (LDS_BYTES - LDSCTL_OFF) / 4; u += 512) ((LAS unsigned*)(lds + LDSCTL_OFF))[u] = 0u;
    __syncthreads();
    if (threadIdx.x == 0) { LAS unsigned long long* t = (LAS unsigned long long*)(lds + PTAB_OFF);
#pragma unroll
        for (int i = 0; i < 32; ++i) t[i] = (unsigned long long)p.in[i];
        t[32] = (unsigned long long)p.out; t[33] = (unsigned long long)p.ws; }
    __syncthreads();
    (void)xcd_barrier_post((unsigned*)(p.ws + WS_CTL) + CW_BAR, MISC + 8);
#ifndef MK_STOP
#define MK_STOP 0
#endif
#define RUN(k) (MK_STOP == 0 || (MK_STOP >= (k) && MK_STOP < 11) || (MK_STOP == 11 && (k) == 1))
#define GRID_BAR() do { unsigned pto2_ = PTAB_OFF; asm volatile("" : "+s"(pto2_)); XcdBarrier b_; \
    b_.bar = (unsigned*)((unsigned char*)ldptr((LAS const unsigned long long*)(lds + pto2_), 33) + WS_CTL) + CW_BAR; b_.x = xb_xcc_id(); b_.st = MISC + 8; xcd_barrier(b_); } while (0)
#define PH_BEGIN() int tid; unsigned pto_ = PTAB_OFF; int G = gridDim.x, bx = blockIdx.x; \
    asm volatile("v_mbcnt_lo_u32_b32 %0, -1, 0\n\tv_mbcnt_hi_u32_b32 %0, -1, %0" : "=v"(tid), "+s"(pto_), "+s"(G), "+s"(bx)); tid += wave_s * 64; \
    const int vcu = (G % 8 == 0) ? (bx % 8) * (G / 8) + bx / 8 : bx, NGW = G * 8, NGT = G * 512; (void)NGW; (void)NGT; \
    LAS const unsigned long long* const pt_ = (LAS const unsigned long long*)(lds + pto_); unsigned char* const ws = (unsigned char*)ldptr(pt_, 33); float* const outp = (float*)ldptr(pt_, 32); (void)outp; \
    const int lane = tid & 63, wave = __builtin_amdgcn_readfirstlane(tid >> 6), gw = vcu * 8 + wave, gt = vcu * 512 + tid; (void)lane; (void)gw; (void)gt
#define MOD ((float*)(ws + WS_MOD))
#define PARTMOD ((float*)(ws + WS_PARTMOD))
#define LAM ((float*)(ws + WS_LAM))
#define ROPE ((float*)(ws + WS_ROPE))
#define TWC ((bf16*)(ws + WS_TWC))
#define TW256 ((bf16*)(ws + WS_TW256))
#define TW1024 ((bf16*)(ws + WS_TW1024))
#define Hb ((bf16*)(ws + WS_H))
#define PROJ ((bf16*)(ws + WS_PROJ))
#define GATES ((bf16*)(ws + WS_GATES))
#define KCTX ((bf16*)(ws + WS_KCTX))
#define VCTX ((bf16*)(ws + WS_VCTX))
#define AO ((float*)(ws + WS_AO))
#define ML ((float*)(ws + WS_ML))
#define BR ((bf16*)(ws + WS_BR))
#define PQC ((bf16*)(ws + WS_PQC))
#define PQL ((bf16*)(ws + WS_PQL))
#define PART ((float*)(ws + WS_PART))
#define MERGED ((bf16*)(ws + WS_MERGED))
#define MIX ((float*)(ws + WS_MIX))
#define SSQ ((float*)(ws + WS_SSQ))
#define FACT ((bf16*)(ws + WS_FACT))
#define X (outp + OUT_Y)
#define IN(i) ldptr(pt_, i)
#define MODl (MOD + (size_t)l * 3 * N_ADA)
#define KLATl ((bf16*)(ws + WS_KLAT + l * SZ_KLAT))
#define VLATl ((bf16*)(ws + WS_VLAT + l * SZ_KLAT))

    {
        PH_BEGIN();
        LAS float* scr = (LAS float*)(lds + wave * 16384);
        constexpr int I_IN = 32 * 192, I_GATE = 32 * 256, I_A = 8 * 64, I_B = 16 * 64, I_C = 8 * 64, I_D = 8 * 64, I_O = 32 * 64, I_UP = 32 * 352, I_DN = 88 * 64;
        constexpr int I_LAYER = I_IN + I_GATE + I_A + I_B + I_C + I_D + I_O + I_UP + I_DN;
        for (int it = gw; it < NL * I_LAYER; it += NGW) {
            const int l = it / I_LAYER; int r = it % I_LAYER;
            const float* W; int N; bf16* WT; int ldw, koff = 0, rowoff = 0, up = 0;
            if (r < I_IN) { W = IN(12) + (size_t)l * DM * DIN_; N = DIN_; WT = (bf16*)(ws + WS_WIG + l * SZ_WIG); ldw = DM; }
            else if ((r -= I_IN) < I_GATE) { W = IN(27) + (size_t)l * DM * NGATE; N = NGATE; WT = (bf16*)(ws + WS_WIG + l * SZ_WIG); ldw = DM; rowoff = DIN_; }
            else if ((r -= I_GATE) < I_A) { W = IN(17) + (size_t)l * 512 * DM; N = DM; WT = (bf16*)(ws + WS_WBR + l * SZ_WBR); ldw = KBR; koff = 0; }
            else if ((r -= I_A) < I_B) { W = IN(23) + (size_t)l * 1024 * DM; N = DM; WT = (bf16*)(ws + WS_WBR + l * SZ_WBR); ldw = KBR; koff = 512; }
            else if ((r -= I_B) < I_C) { W = IN(25) + (size_t)l * 512 * DM; N = DM; WT = (bf16*)(ws + WS_WBR + l * SZ_WBR); ldw = KBR; koff = 1536; }
            else if ((r -= I_C) < I_D) { W = IN(26) + (size_t)l * 512 * DM; N = DM; WT = (bf16*)(ws + WS_WBR + l * SZ_WBR); ldw = KBR; koff = 2048; }
            else if ((r -= I_D) < I_O) { W = IN(29) + (size_t)l * DM * DM; N = DM; WT = (bf16*)(ws + WS_WO + l * SZ_WO); ldw = DM; }
            else if ((r -= I_O) < I_UP) { W = IN(30) + (size_t)l * DM * NUP; N = NUP; WT = (bf16*)(ws + WS_WUP + l * SZ_WUP); ldw = DM; up = 1; }
            else { r -= I_UP; W = IN(31) + (size_t)l * DFF * DM; N = DM; WT = (bf16*)(ws + WS_WDN + l * SZ_WDN); ldw = DFF; }
            transpose_item(W, N, WT, ldw, koff, rowoff, up, scr, r, lane);
        }
        for (int it = gw; it < NL * 32 * 48; it += NGW) {
            const int l = it / 1536, r = it % 1536, ks = r / 48, nc = r % 48, k0 = ks * 64, n = nc * 256 + 4 * lane;
            float c0 = IN(5)[k0 + lane], c1 = IN(4)[k0 + lane], c2 = IN(4)[DM + k0 + lane];
            c0 = c0 / (1.0f + __expf(-c0)); c1 = c1 / (1.0f + __expf(-c1)); c2 = c2 / (1.0f + __expf(-c2));
            const float* wp = IN(6) + ((size_t)l * DM + k0) * N_ADA + n;
            f32x4 a0 = {0.f, 0.f, 0.f, 0.f}, a1 = a0, a2 = a0;
#pragma unroll 8
            for (int k = 0; k < 64; ++k) { const f32x4 w = *(const f32x4*)(wp + (size_t)k * N_ADA);
                const float s0 = __shfl(c0, k), s1 = __shfl(c1, k), s2 = __shfl(c2, k); a0 += w * s0; a1 += w * s1; a2 += w * s2; }
            float* po = PARTMOD + ((size_t)(l * 32 + ks) * 3) * N_ADA + n;
            *(f32x4*)(po) = a0; *(f32x4*)(po + N_ADA) = a1; *(f32x4*)(po + 2 * N_ADA) = a2;
        }
        for (int i = gt; i < 2 * 524288; i += NGT) {
            const int t = i >= 524288 ? 1 : 0, j = i - t * 524288; const size_t e = (size_t)j * 8;
            const int b = (int)(e >> 21), l = (int)(e >> 19) & 3, tt = (int)(e >> 10) & 511, c = (int)e & 1023;
            const float* src = (t ? IN(3) : IN(2)) + e; const f32x4 v0 = *(const f32x4*)src, v1 = *(const f32x4*)(src + 4);
            v4u o; o.x = pk2(v0[0], v0[1]); o.y = pk2(v0[2], v0[3]); o.z = pk2(v1[0], v1[1]); o.w = pk2(v1[2], v1[3]);
            bf16* dst = (bf16*)(ws + (t ? WS_VLAT : WS_KLAT) + l * SZ_KLAT) + ((size_t)(b * 1536 + tt)) * 1024 + c;
            *(v4u*)dst = o;
        }
        for (int i = gt; i < 512 * 256; i += NGT) { const int mr = i >> 8, kk = i & 255, gg = mr >> 8, pq = (mr >> 7) & 1, j = mr & 127, gg2 = kk >> 7, c = kk & 127;
            const float ang = (float)((j * c) & 127) * (2.0f / 128.0f); float v = pq ? sinpif(ang) : cospif(ang); v *= 0.08838834764831845f;
            TWC[i] = (bf16)f2bf(gg == gg2 ? v : 0.f); }
        for (int i = gt; i < 256 * 512; i += NGT) { const int k = i >> 9, kk = i & 511, pq = kk >> 8, t = kk & 255; const float ang = (float)((k * t) & 255) * (2.0f / 256.0f);
            const float v = (pq ? -sinpif(ang) : cospif(ang)) * 0.0625f; TW256[i] = (bf16)f2bf(v); }
        for (int i = gt; i < 1024 * 2048; i += NGT) { const int k = i >> 11, kk = i & 2047, pq = kk >> 10, t = kk & 1023; const float ang = (float)((k * t) & 1023) * (2.0f / 1024.0f);
            const float v = (pq ? -sinpif(ang) : cospif(ang)) * 0.03125f; TW1024[i] = (bf16)f2bf(v); }
        for (int i = gt; i < 64 * 32; i += NGT) { const int pos = i >> 5, fi = i & 31; const float inv = powf(10000.0f, -(float)(2 * fi) / 64.0f); const float a = (float)pos * inv;
            ROPE[2 * i] = cosf(a); ROPE[2 * i + 1] = sinf(a); }
        if (gt < NL) { const int l = gt; float s1 = 0.f, s2 = 0.f;
            for (int k = 0; k < 128; ++k) { s1 += IN(18)[l * 128 + k] * IN(19)[l * 128 + k]; s2 += IN(20)[l * 128 + k] * IN(21)[l * 128 + k]; }
            const float li = 0.8f - 0.6f * expf(-0.3f * (float)l); LAM[2 * l] = expf(s1) - expf(s2) + li; LAM[2 * l + 1] = 1.0f - li; }
    }
    GRID_BAR();
    { PH_BEGIN();
    for (int i = gt; i < NL * 3 * N_ADA; i += NGT) { const int l = i / (3 * N_ADA), r = i % (3 * N_ADA), v = r / N_ADA, n = r % N_ADA; float s = IN(7)[l * N_ADA + n];
        for (int ks = 0; ks < 32; ++ks) s += PARTMOD[((size_t)(l * 32 + ks) * 3 + v) * N_ADA + n];
        MOD[i] = s; } }
    GRID_BAR();
    { PH_BEGIN(); row_phase<false>(gw, NGW, lane, IN(0), IN(1), X, nullptr, nullptr, nullptr, nullptr, true, IN(8), MOD + 2048, MOD, Hb); }
    GRID_BAR();

    int nlayers = MK_LAYERS; asm volatile("" : "+s"(nlayers));
    for (int l = 0; l < nlayers; ++l) {
        if (RUN(1)) {
            PH_BEGIN();
            pg8::TileSched S{24, 56, G, bx, 32, (const char*)Hb, (const char*)(ws + WS_WIG + l * SZ_WIG), (size_t)256 * DM * 2, (size_t)256 * DM * 2};
            pg8::EpiG1 E{PROJ, GATES, KCTX, VCTX, KLATl, VLATl, outp + OUT_NK + (size_t)l * 256 * 1024, outp + OUT_NV + (size_t)l * 256 * 1024, IN(28) + (size_t)l * NGATE};
            pg8::gemm_stream<pg8::EpiG1, pg8::TileSched>(lds, tid, DM, DM, S, E);
        }
        GRID_BAR();
        if (RUN(2)) {
            { PH_BEGIN();
            for (int i = gt; i < 2048 * 128; i += NGT) {
                const int tok = i >> 7, r = i & 127, tensor = r >> 6, h = (r >> 4) & 3, m = (r >> 3) & 1, half = (r >> 2) & 1, j8 = r & 3;
                const int b = tok >> 10, t = tok & 1023, pos = half ? (t & 63) : (t >> 6);
                bf16* q = tensor == 0 ? PROJ + (size_t)(MCTX + tok) * DIN_ + 1024 : KLATl + (size_t)(b * 1536 + 512 + t) * 1024;
                q += h * 256 + m * 128 + half * 64 + j8 * 8;
                const v4u x1 = *(const v4u*)q, x2 = *(const v4u*)(q + 32);
                const float* cs = ROPE + (size_t)(pos * 32 + j8 * 8) * 2;
                const f32x4 t0 = *(const f32x4*)cs, t1 = *(const f32x4*)(cs + 4), t2 = *(const f32x4*)(cs + 8), t3 = *(const f32x4*)(cs + 12);
                const float co[8] = {t0[0], t0[2], t1[0], t1[2], t2[0], t2[2], t3[0], t3[2]}, si[8] = {t0[1], t0[3], t1[1], t1[3], t2[1], t2[3], t3[1], t3[3]};
                const unsigned xa[4] = {x1.x, x1.y, x1.z, x1.w}, xb[4] = {x2.x, x2.y, x2.z, x2.w}; unsigned oa[4], ob[4];
#pragma unroll
                for (int e = 0; e < 4; ++e) { const float a0 = bf_lo(xa[e]), a1 = bf_hi(xa[e]), b0 = bf_lo(xb[e]), b1 = bf_hi(xb[e]);
                    oa[e] = pk2(a0 * co[2 * e] - b0 * si[2 * e], a1 * co[2 * e + 1] - b1 * si[2 * e + 1]);
                    ob[e] = pk2(b0 * co[2 * e] + a0 * si[2 * e], b1 * co[2 * e + 1] + a1 * si[2 * e + 1]); }
                *(v4u*)q = (v4u){oa[0], oa[1], oa[2], oa[3]}; *(v4u*)(q + 32) = (v4u){ob[0], ob[1], ob[2], ob[3]};
            }
            }
            {
                PH_BEGIN();
                const float* wc3 = IN(24) + (size_t)l * 3 * 512;
                for (int i = gt; i < MTOK * 64; i += NGT) {
                    const int row = i >> 6, c8 = (i & 63) * 8; int s0, T; if (row < MCTX) { s0 = row & ~255; T = 256; } else { s0 = MCTX + ((row - MCTX) & ~1023); T = 1024; }
                    float acc8[8] = {0.f, 0.f, 0.f, 0.f, 0.f, 0.f, 0.f, 0.f};
#pragma unroll
                    for (int dk = 0; dk < 3; ++dk) { const int g = row + dk - 1;
                        if (g >= s0 && g < s0 + T) { const bf16* pr = PROJ + (size_t)g * DIN_ + c8; const v4u sc = *(const v4u*)(pr + 4608), sx = *(const v4u*)(pr + 5120);
                            const f32x4 w0 = *(const f32x4*)(wc3 + dk * 512 + c8), w1 = *(const f32x4*)(wc3 + dk * 512 + c8 + 4);
                            const unsigned sa[4] = {sc.x, sc.y, sc.z, sc.w}, sb[4] = {sx.x, sx.y, sx.z, sx.w}; const float wv[8] = {w0[0], w0[1], w0[2], w0[3], w1[0], w1[1], w1[2], w1[3]};
#pragma unroll
                            for (int e = 0; e < 4; ++e) { acc8[2 * e] += wv[2 * e] * (bf_lo(sa[e]) * bf_lo(sb[e])); acc8[2 * e + 1] += wv[2 * e + 1] * (bf_hi(sa[e]) * bf_hi(sb[e])); } } }
                    const v4u sbv = *(const v4u*)(PROJ + (size_t)row * DIN_ + 4096 + c8); const unsigned sbb[4] = {sbv.x, sbv.y, sbv.z, sbv.w}; unsigned o[4];
#pragma unroll
                    for (int e = 0; e < 4; ++e) o[e] = pk2(bf_lo(sbb[e]) * acc8[2 * e], bf_hi(sbb[e]) * acc8[2 * e + 1]);
                    *(v4u*)(BR + (size_t)row * KBR + 1536 + c8) = (v4u){o[0], o[1], o[2], o[3]};
                }
            }
            {
                PH_BEGIN();
                const int c = tid; float w[31];
#pragma unroll
                for (int k = 0; k < 31; ++k) w[k] = IN(13)[((size_t)l * 31 + k) * 512 + c];
                const float cb = IN(14)[l * 512 + c];
                LAS float* so = (LAS float*)lds;
                for (int u = vcu; u < MTOK / 16; u += G) {
                    const int row0 = u * 16; int s0, T; if (row0 < MCTX) { s0 = row0 & ~255; T = 256; } else { s0 = MCTX + ((row0 - MCTX) & ~1023); T = 1024; }
                    float in[46];
#pragma unroll
                    for (int r = 0; r < 46; ++r) { const int g = row0 - 15 + r; float v = 0.f;
                        if (g >= s0 && g < s0 + T) { const bf16* pr = PROJ + (size_t)g * DIN_ + c; v = bf2f(pr[0]) * sigmoid_f(bf2f(pr[512])); }
                        in[r] = v; }
#pragma unroll
                    for (int t = 0; t < 16; ++t) { float o = cb;
#pragma unroll
                        for (int k = 0; k < 31; ++k) o += w[k] * in[t + k];
                        so[t * 512 + c] = o; }
                    __syncthreads();
#pragma unroll
                    for (int q = 0; q < 2; ++q) { const int t = 2 * wave + q; float v[8]; float s = 0.f;
#pragma unroll
                        for (int j = 0; j < 8; ++j) { v[j] = so[t * 512 + lane + 64 * j]; s += v[j]; }
                        const float mean = wave_sum(s) * (1.0f / 512.0f); float s2 = 0.f;
#pragma unroll
                        for (int j = 0; j < 8; ++j) { v[j] -= mean; s2 += v[j] * v[j]; }
                        const float rstd = __builtin_amdgcn_rsqf(wave_sum(s2) * (1.0f / 512.0f) + EPS_);
#pragma unroll
                        for (int j = 0; j < 8; ++j) { const int cc = lane + 64 * j; float y = v[j] * rstd * IN(15)[l * 512 + cc] + IN(16)[l * 512 + cc]; y = y * sigmoid_f(y);
                            BR[(size_t)(row0 + t) * KBR + cc] = (bf16)f2bf(y); } }
                    __syncthreads();
                }
            }
            {
                PH_BEGIN();
                int nt4 = 4; asm volatile("" : "+s"(nt4));
                pg8::SchedF1 S{G, bx, nt4, (const char*)TWC, (const char*)PROJ};
                pg8::EpiF1 E{PQC, PQL};
                pg8::gemm_stream<pg8::EpiF1, pg8::SchedF1>(lds, tid, 256, DIN_, S, E);
            }
        }
        GRID_BAR();
        if (RUN(3)) {
            { PH_BEGIN();
            for (int ui = vcu; ui < 512; ui += G) {
                const bf16 *Q, *K, *V; float *Ob, *MLb; int seq;
                if (ui < 256) { const int u = ui, split = u & 1, qb = (u >> 1) & 3, vh = (u >> 3) & 1, m = (u >> 4) & 1, h = (u >> 5) & 3, b = u >> 7;
                    const int tok0 = MCTX + b * 1024 + qb * 256, slot = (h * 2 + m) * 2 + vh;
                    Q = PROJ + (size_t)tok0 * DIN_ + 1024 + h * 256 + m * 128;
                    K = KLATl + (size_t)(b * 1536 + split * 768) * 1024 + h * 256 + m * 128; V = VLATl + (size_t)(b * 1536 + split * 768) * 1024 + h * 256 + vh * 128;
                    Ob = AO + ((size_t)split * MTOK + tok0) * 2048 + slot * 128; MLb = ML + (((size_t)split * 16 + slot) * MTOK + tok0) * 2; seq = 768; }
                else { const int u = ui - 256, vh = u & 1, m = (u >> 1) & 1, h = (u >> 2) & 3, s = u >> 4; const int tok0 = s * 256, slot = (h * 2 + m) * 2 + vh;
                    Q = PROJ + (size_t)tok0 * DIN_ + 1024 + h * 256 + m * 128;
                    K = KCTX + (size_t)tok0 * 1024 + h * 256 + m * 128; V = VCTX + (size_t)tok0 * 1024 + h * 256 + vh * 128;
                    Ob = AO + (size_t)tok0 * 2048 + slot * 128; MLb = ML + ((size_t)slot * MTOK + tok0) * 2; seq = 256; }
                att::attn_unit(Q, K, V, Ob, MLb, seq, (LAS char*)lds, tid);
            } }
            {
                PH_BEGIN();
                pg8::SchedF2L S{bx, (const char*)TW1024, (const char*)PQL};
                pg8::EpiBf16 E{BR, KBR, 2048};
                pg8::gemm_stream<pg8::EpiBf16, pg8::SchedF2L>(lds, tid, 2048, 2048, S, E);
            }
            {
                PH_BEGIN();
                pg8::SchedF2C S{bx, (const char*)TW256, (const char*)PQC};
                pg8::EpiBf16 E{BR, KBR, 2048};
                pg8::gemm_stream<pg8::EpiBf16, pg8::SchedF2C>(lds, tid, 512, 512, S, E);
            }
        }
        GRID_BAR();
        if (RUN(4)) {
            PH_BEGIN();
            const float lam = LAM[2 * l], oml = LAM[2 * l + 1]; constexpr float C = att::SCALE * 1.4426950408889634f;
            for (int it = gw; it < MTOK * 4; it += NGW) {
                const int tok = it >> 2, h = it & 3, vh = lane >> 5, d4 = (lane & 31) * 4; const bool two = tok >= MCTX;
                f32x4 val[2];
#pragma unroll
                for (int m = 0; m < 2; ++m) { const int slot = (h * 2 + m) * 2 + vh;
                    const f32x4 o0 = *(const f32x4*)(AO + (size_t)tok * 2048 + slot * 128 + d4); const float m0 = ML[((size_t)slot * MTOK + tok) * 2], l0 = ML[((size_t)slot * MTOK + tok) * 2 + 1];
                    if (two) { const f32x4 o1 = *(const f32x4*)(AO + ((size_t)MTOK + tok) * 2048 + slot * 128 + d4); const float m1 = ML[((size_t)(16 + slot) * MTOK + tok) * 2], l1 = ML[((size_t)(16 + slot) * MTOK + tok) * 2 + 1];
                        const float mm = fmaxf(m0, m1), e0 = __builtin_amdgcn_exp2f((m0 - mm) * C), e1 = __builtin_amdgcn_exp2f((m1 - mm) * C);
                        val[m] = (o0 * e0 + o1 * e1) * (1.0f / (l0 * e0 + l1 * e1)); }
                    else val[m] = o0 * (1.0f / l0); }
                const f32x4 o = val[0] - val[1] * lam;
                const float ss = wave_sum((o[0] * o[0] + o[1] * o[1]) + (o[2] * o[2] + o[3] * o[3]));
                const float rs = __builtin_amdgcn_rsqf(ss * (1.0f / 256.0f) + EPS_) * oml;
                const f32x4 g = *(const f32x4*)(IN(22) + l * 256 + vh * 128 + d4); const f32x4 r = o * rs * g;
                v2u w; w.x = pk2(r[0], r[1]); w.y = pk2(r[2], r[3]); *(v2u*)(BR + (size_t)tok * KBR + 512 + h * 256 + vh * 128 + d4) = w;
            }
        }
        GRID_BAR();
        if (RUN(5)) {
            PH_BEGIN();
            pg8::SchedG2 S{G, bx, (const char*)BR, (const char*)(ws + WS_WBR + l * SZ_WBR)};
            pg8::EpiG2 E{GATES, PART, MERGED};
            pg8::gemm_stream<pg8::EpiG2, pg8::SchedG2>(lds, tid, KBR, KBR, S, E);
        }
        GRID_BAR();
        if (RUN(6)) {
            PH_BEGIN();
            pg8::TileSched S{24, 8, G, bx, 32, (const char*)MERGED, (const char*)(ws + WS_WO + l * SZ_WO), (size_t)256 * DM * 2, (size_t)256 * DM * 2};
            pg8::EpiSsq E{MIX, SSQ};
            pg8::gemm_stream<pg8::EpiSsq, pg8::TileSched>(lds, tid, DM, DM, S, E);
        }
        GRID_BAR();
        if (RUN(7)) { PH_BEGIN(); row_phase<true>(gw, NGW, lane, X, X + (size_t)MCTX * DM, X, MIX, SSQ, MODl + 4096, IN(9) + l * DM, true, IN(10) + l * DM, MODl + 8192, MODl + 6144, Hb); }
        GRID_BAR();
        if (RUN(8)) {
            PH_BEGIN();
            pg8::TileSched S{24, 44, G, bx, 32, (const char*)Hb, (const char*)(ws + WS_WUP + l * SZ_WUP), (size_t)256 * DM * 2, (size_t)256 * DM * 2};
            pg8::EpiSwiGLU E{FACT};
            pg8::gemm_stream<pg8::EpiSwiGLU, pg8::TileSched>(lds, tid, DM, DM, S, E);
        }
        GRID_BAR();
        if (RUN(9)) {
            PH_BEGIN();
            pg8::TileSched S{24, 8, G, bx, 88, (const char*)FACT, (const char*)(ws + WS_WDN + l * SZ_WDN), (size_t)256 * DFF * 2, (size_t)256 * DFF * 2};
            pg8::EpiSsq E{MIX, SSQ};
            pg8::gemm_stream<pg8::EpiSsq, pg8::TileSched>(lds, tid, DFF, DFF, S, E);
        }
        GRID_BAR();
        if (RUN(10)) {
            PH_BEGIN();
            const bool more = (l + 1 < NL); const int ln = more ? l + 1 : l;
            row_phase<true>(gw, NGW, lane, X, X + (size_t)MCTX * DM, X, MIX, SSQ, MODl + 10240, IN(11) + l * DM, more, IN(8) + ln * DM, MOD + (size_t)ln * 3 * N_ADA + 2048, MOD + (size_t)ln * 3 * N_ADA, Hb);
        }
        if (l + 1 < nlayers) GRID_BAR();
    }
#if MK_STOP
    { GRID_BAR(); PH_BEGIN();
      for (size_t i = gt; i < (size_t)MTOK * DM; i += NGT) { const size_t row = i >> 11; const int col = (int)(i & 2047); float v = 0.f;
        if (MK_STOP == 2) v = col < 512 ? bf2f(BR[row * KBR + col]) : (col < 1024 ? bf2f(BR[row * KBR + 1536 + col - 512]) : bf2f(PROJ[row * DIN_ + col]));
        else if (MK_STOP == 3) v = AO[row * 2048 + col];
        else if (MK_STOP == 4) v = col < 1024 ? bf2f(BR[row * KBR + 512 + col]) : (col < 1536 ? bf2f(BR[row * KBR + 2048 + col - 1024]) : 0.f);
        else if (MK_STOP == 5) v = bf2f(MERGED[i]);
        else if (MK_STOP == 6 || MK_STOP == 9) v = MIX[i];
        else if (MK_STOP == 8) v = bf2f(FACT[row * DFF + col]);
        else if (MK_STOP == 11) v = (bf2f(GATES[row * NGATE + col]) + bf2f(GATES[row * NGATE + 2048 + col])) + (bf2f(GATES[row * NGATE + 4096 + col]) + bf2f(GATES[row * NGATE + 6144 + col]));
        else continue;
        X[i] = v; } }
#endif
#if MK_LAYERS < 4
    PH_BEGIN();
    for (size_t i = gt; i < (size_t)16 * 4 * 256 * 1024; i += NGT) { const int l = (int)((i >> 18) & 3); if (l >= MK_LAYERS) { outp[OUT_NK + i] = 0.f; outp[OUT_NV + i] = 0.f; } }
#endif
#undef GRID_BAR
}

extern "C" void kernel_launch(void* const* d_in, const int* in_sizes, int n_in, void* d_out, int out_size, void* d_ws, size_t ws_size, hipStream_t stream) {
    static int grid = 0;
    if (grid == 0) {
        if (n_in != 32 || (size_t)out_size != OUT_TOTAL || ws_size < WS_END) { fprintf(stderr, "kernel_launch: built for 32 inputs, %zu outputs, >= %zu bytes of workspace; got n_in %d, out %d, ws %zu; nothing launched\n", OUT_TOTAL, (size_t)WS_END, n_in, out_size, ws_size); grid = -1; return; }
        int dev = 0, cus = 0, per_cu = 0;
        if (hipGetDevice(&dev) != hipSuccess || hipDeviceGetAttribute(&cus, hipDeviceAttributeMultiprocessorCount, dev) != hipSuccess) { fprintf(stderr, "kernel_launch: device query failed\n"); grid = -1; return; }
        if (hipFuncSetAttribute((const void*)mk_fwd, hipFuncAttributeMaxDynamicSharedMemorySize, LDS_BYTES) != hipSuccess) { fprintf(stderr, "kernel_launch: hipFuncSetAttribute failed\n"); grid = -1; return; }
        if (hipOccupancyMaxActiveBlocksPerMultiprocessor(&per_cu, (const void*)mk_fwd, 512, LDS_BYTES) != hipSuccess || per_cu < 1) { fprintf(stderr, "kernel_launch: occupancy query reports %d workgroups per CU\n", per_cu); }
        (void)hipGetLastError();
        grid = cus;
    }
    if (grid < 0) return;
#ifdef MK_ZERO_WS
    (void)hipMemsetAsync((char*)d_ws, 0, WS_END, stream);
#endif
    if (hipMemsetAsync((char*)d_ws + WS_CTL, 0, CTL_ZERO_BYTES, stream) != hipSuccess) { fprintf(stderr, "kernel_launch: hipMemsetAsync failed\n"); return; }
    Params p{};
    for (int i = 0; i < 32; ++i) p.in[i] = (const float*)d_in[i];
    p.out = (float*)d_out; p.ws = (unsigned char*)d_ws;
    hipLaunchKernelGGL(mk_fwd, dim3(grid), dim3(512), LDS_BYTES, stream, p);
    const hipError_t le = hipPeekAtLastError();
    if (le != hipSuccess) fprintf(stderr, "kernel_launch: launch failed: %s\n", hipGetErrorName(le));
}
```

```cpp
#include <hip/hip_runtime.h>
#include <cstdio>
#include <cstdint>

#ifndef MK_LAYERS
#define MK_LAYERS 4
#endif

#define GAS __attribute__((address_space(1)))
#define LAS __attribute__((address_space(3)))
typedef unsigned short bf16;
typedef unsigned v4u __attribute__((ext_vector_type(4)));
typedef unsigned v2u __attribute__((ext_vector_type(2)));
typedef float f32x4 __attribute__((ext_vector_type(4)));
typedef float f32x8 __attribute__((ext_vector_type(8)));
typedef float f32x16 __attribute__((ext_vector_type(16)));
typedef short bf16x8 __attribute__((ext_vector_type(8)));
typedef short s16x4 __attribute__((ext_vector_type(4)));
typedef GAS unsigned gu32;
#define RLX_AGENT __ATOMIC_RELAXED, __HIP_MEMORY_SCOPE_AGENT
#define LDS_WAIT() asm volatile("s_waitcnt lgkmcnt(0)" ::: "memory")
#define VM_WAIT() asm volatile("s_waitcnt vmcnt(0)" ::: "memory")
__device__ __forceinline__ unsigned f2bf(float f) { unsigned u = __builtin_bit_cast(unsigned, f); return (u + 0x7fffu + ((u >> 16) & 1u)) >> 16; }
__device__ __forceinline__ unsigned pk2(float lo, float hi) { return f2bf(lo) | (f2bf(hi) << 16); }
__device__ __forceinline__ float bf_lo(unsigned w) { return __builtin_bit_cast(float, w << 16); }
__device__ __forceinline__ float bf_hi(unsigned w) { return __builtin_bit_cast(float, w & 0xffff0000u); }
__device__ __forceinline__ float bf2f(bf16 b) { return __builtin_bit_cast(float, ((unsigned)b) << 16); }
__device__ __forceinline__ float sigmoid_f(float x) { return __builtin_amdgcn_rcpf(1.0f + __builtin_amdgcn_exp2f(-1.4426950408889634f * x)); }
typedef float f32x2c_t __attribute__((ext_vector_type(2)));
typedef __bf16 bf16x2c_t __attribute__((ext_vector_type(2)));
__device__ __forceinline__ unsigned cvt_pk_bf16_c(float lo, float hi) { f32x2c_t v = {lo, hi}; bf16x2c_t b = __builtin_convertvector(v, bf16x2c_t); return __builtin_bit_cast(unsigned, b); }
__device__ __forceinline__ float wave_sum(float v) {
#pragma unroll
    for (int o = 1; o < 64; o <<= 1) v += __shfl_xor(v, o);
    return v;
}

namespace pg8 {
#define PG8_LAS __attribute__((address_space(3)))
typedef unsigned short bf16_t;
typedef unsigned u32x4 __attribute__((ext_vector_type(4)));
typedef unsigned u32x2 __attribute__((ext_vector_type(2)));
constexpr int BM = 256, BK = 64, HALF = 128, HTB = HALF * BK * 2  , STAGE_BYTES = 8 * HTB, NXCD = 8, WGM = 8;

__host__ __device__ __forceinline__ int lds_byte(int r, int c) { const int st = (r >> 4) * 2 + (c >> 5), rr = r & 15, cc = c & 31, ob = rr * 64 + cc * 2; return st * 1024 + (ob ^ (((ob >> 9) & 1) << 5)); }
__host__ __device__ __forceinline__ void stage_rc(int b, int& R, int& C) { const int st = b / 1024, sb = b % 1024, swz = sb ^ (((sb >> 9) & 1) << 5); R = (st >> 1) * 16 + swz / 64; C = (st & 1) * 32 + (swz % 64) / 2; }
__host__ __device__ __forceinline__ int perm32(int rho) { const int n = rho >> 4, i = rho & 15; return 8 * (i >> 2) + 4 * n + (i & 3); }

struct Unit { int pm, pn, aux, nt; const char* A; const char* B; };

__device__ __forceinline__ bool tile_order(long L, int nM, int nN, int& pm, int& pn) {
    const int nwg = nM * nN; if (L >= nwg) return false;
    int wgid = (int)L; { const int q = nwg / NXCD, r = nwg % NXCD, xcd = wgid % NXCD, off = wgid / NXCD; wgid = (xcd < r ? xcd * (q + 1) : r * (q + 1) + (xcd - r) * q) + off; }
    const int nig = WGM * nN, gid = wgid / nig, fm = gid * WGM, gsz = (nM - fm) < WGM ? (nM - fm) : WGM;
    pm = fm + ((wgid % nig) % gsz); pn = (wgid % nig) / gsz; return true;
}
struct TileSched {
    int nM, nN, G, c, nt; const char* A; const char* B; size_t strideA, strideB;
    __device__ __forceinline__ bool next(int i, Unit& u) const {
        int pm, pn; if (!tile_order((long)i * G + c, nM, nN, pm, pn)) return false;
        u.pm = pm; u.pn = pn; u.aux = 0; u.nt = nt; u.A = A + (size_t)pm * strideA; u.B = B + (size_t)pn * strideB; return true;
    }
};

__device__ __forceinline__ unsigned cvt_pk_bf16(float lo, float hi) { return cvt_pk_bf16_c(lo, hi); }

template <class Epi, class Sched, int MI = 4, bool ALIGN_EPI = true, bool SP2 = true>
__device__ __forceinline__ void gemm_stream(PG8_LAS unsigned char* lds, const int tid, const int lda, const int ldb, const Sched& S, const Epi& E) {
    const int wid = __builtin_amdgcn_readfirstlane(tid >> 6), lane = tid & 63, wr = wid >> 2, wc = wid & 3, fr = lane & 15, fq = lane >> 4;
    unsigned voffA[2], voffB[2];
#pragma unroll
    for (int i = 0; i < 2; ++i) { int R, C; stage_rc(tid * 16 + i * 8192, R, C); const int Rb = Epi::PERM ? ((R & ~31) + perm32(R & 31)) : R;
        voffA[i] = (unsigned)(R * lda + C) * 2u; voffB[i] = (unsigned)(Rb * ldb + C) * 2u; }
    const size_t kstep = (size_t)(BK * 2);
    static_assert(MI == 4 || ((MI == 3 || MI == 2 || MI == 1) && SP2), "192-, 128- and 64-row units need the SP2 schedule");
    const bool issue2 = (MI == 4) || (MI == 3 && wr == 0), issue1 = (MI >= 2) || (wr == 0);
    const size_t hstepA = (size_t)(32 * MI) * lda * 2, hstepB = (size_t)HALF * ldb * 2;
    const unsigned ldsw = (unsigned)wid * 1024u;
    const int aoff = lds_byte(wr * (16 * MI) + fr, fq * 8), boff = lds_byte(wc * 32 + fr, fq * 8);
#define PG8_SA(b, h) (((b) * 2 + (h)) * HTB)
#define PG8_SB(b, h) ((4 + (b) * 2 + (h)) * HTB)
#define PG8_STAGE(bufoff, gbase, voff) do { _Pragma("unroll") for (int _i = 0; _i < 2; ++_i) \
        __builtin_amdgcn_global_load_lds((const unsigned*)((const char*)(gbase) + (voff)[_i]), (PG8_LAS unsigned*)(lds + (bufoff) + ldsw + _i * 8192), 16, 0, 0); } while (0)
#define PG8_STAGE_A(bufoff, gbase) do { if (issue1) __builtin_amdgcn_global_load_lds((const unsigned*)((const char*)(gbase) + voffA[0]), (PG8_LAS unsigned*)(lds + (bufoff) + ldsw), 16, 0, 0); \
        if (issue2) __builtin_amdgcn_global_load_lds((const unsigned*)((const char*)(gbase) + voffA[1]), (PG8_LAS unsigned*)(lds + (bufoff) + ldsw + 8192), 16, 0, 0); } while (0)
#define PG8_WAIT_VH(nlead, ntrail) do { if (issue2) asm volatile("s_waitcnt vmcnt(" #nlead ")" ::: "memory"); else if (issue1) asm volatile("s_waitcnt vmcnt(" #ntrail ")" ::: "memory"); \
        else { if ((ntrail) == 1) asm volatile("s_waitcnt vmcnt(0)" ::: "memory"); else asm volatile("s_waitcnt vmcnt(4)" ::: "memory"); } } while (0)
#define PG8_LDA(dst, b, h) do { _Pragma("unroll") for (int m = 0; m < MI; ++m) _Pragma("unroll") for (int k = 0; k < 2; ++k) dst[m][k] = *(const PG8_LAS bf16x8*)(lds + PG8_SA(b, h) + aoff + m * 2048 + k * 1024); } while (0)
#define PG8_LDB(dst, b, h) do { _Pragma("unroll") for (int n = 0; n < 2; ++n) _Pragma("unroll") for (int k = 0; k < 2; ++k) dst[n][k] = *(const PG8_LAS bf16x8*)(lds + PG8_SB(b, h) + boff + n * 2048 + k * 1024); } while (0)
#define PG8_MMA(ai, bj, At, Bt) do { __builtin_amdgcn_s_setprio(1); _Pragma("unroll") for (int m = 0; m < MI; ++m) _Pragma("unroll") for (int n = 0; n < 2; ++n) _Pragma("unroll") for (int k = 0; k < 2; ++k) \
        acc[ai][bj][m][n] = __builtin_amdgcn_mfma_f32_16x16x32_bf16(Bt[n][k], At[m][k], acc[ai][bj][m][n], 0, 0, 0); __builtin_amdgcn_s_setprio(0); } while (0)
#define PG8_WAIT_V(n) asm volatile("s_waitcnt vmcnt(" #n ")" ::: "memory")
#define PG8_WAIT_L(n) asm volatile("s_waitcnt lgkmcnt(" #n ")" ::: "memory")
#define PG8_BAR __builtin_amdgcn_s_barrier()
#define PG8_SCHED __builtin_amdgcn_sched_barrier(0)
    Unit cur, nxt; int ui = 0;
    if (!S.next(0, cur)) return;
    f32x4 acc[2][2][MI][2];
#pragma unroll
    for (int a = 0; a < 2; ++a)
#pragma unroll
        for (int b = 0; b < 2; ++b)
#pragma unroll
            for (int m = 0; m < MI; ++m)
#pragma unroll
                for (int n = 0; n < 2; ++n) acc[a][b][m][n] = (f32x4){0.f, 0.f, 0.f, 0.f};
    bf16x8 At[MI][2], B0[2][2], B1[2][2];
    const char* cA = cur.A; const char* cB = cur.B;
    if constexpr (SP2) {
        PG8_STAGE(PG8_SB(0, 0), cB, voffB); PG8_STAGE(PG8_SB(0, 1), cB + hstepB, voffB); PG8_STAGE_A(PG8_SA(0, 0), cA); PG8_STAGE_A(PG8_SA(0, 1), cA + hstepA);
        if (wr == 1) PG8_BAR;
        PG8_WAIT_VH(2, 1); PG8_BAR;
        PG8_STAGE(PG8_SB(1, 0), cB + kstep, voffB); PG8_STAGE_A(PG8_SA(1, 0), cA + kstep); PG8_STAGE(PG8_SB(1, 1), cB + hstepB + kstep, voffB);
        PG8_WAIT_VH(6, 5); PG8_BAR;
    } else {
        PG8_STAGE(PG8_SB(0, 0), cB, voffB); PG8_STAGE(PG8_SA(0, 0), cA, voffA); PG8_STAGE(PG8_SB(0, 1), cB + hstepB, voffB); PG8_STAGE(PG8_SA(0, 1), cA + hstepA, voffA);
        if (wr == 1) PG8_BAR;
        PG8_WAIT_V(4); PG8_BAR;
        PG8_STAGE(PG8_SB(1, 0), cB + kstep, voffB); PG8_STAGE(PG8_SA(1, 0), cA + kstep, voffA); PG8_STAGE(PG8_SB(1, 1), cB + hstepB + kstep, voffB);
        PG8_WAIT_V(6); PG8_BAR;
    }
    for (;;) {
        const bool has_next = S.next(ui + 1, nxt);
        const int nt = cur.nt;
        const char* nA = has_next ? nxt.A : cA; const char* nB = has_next ? nxt.B : cB;
        for (int t = 0; t < nt; t += 2) {
            const bool last = (t == nt - 2);
            const char* a1 = cA + (size_t)(t + 1) * kstep;
            const char* a2 = last ? nA : cA + (size_t)(t + 2) * kstep; const char* b2 = last ? nB : cB + (size_t)(t + 2) * kstep;
            const char* a3 = a2 + kstep; const char* b3 = b2 + kstep;
            if constexpr (SP2) {
            PG8_LDB(B0, 0, 0); PG8_LDB(B1, 0, 1); PG8_SCHED; PG8_LDA(At, 0, 0); PG8_STAGE_A(PG8_SA(1, 1), a1 + hstepA);
            PG8_WAIT_VH(8, 6); PG8_WAIT_L(0); PG8_BAR; PG8_MMA(0, 0, At, B0); PG8_MMA(0, 1, At, B1); PG8_BAR; PG8_SCHED;
            PG8_LDA(At, 0, 1); PG8_STAGE(PG8_SB(0, 0), b2, voffB); PG8_STAGE(PG8_SB(0, 1), b2 + hstepB, voffB); PG8_STAGE_A(PG8_SA(0, 0), a2);
            PG8_WAIT_VH(8, 6); PG8_WAIT_L(0); PG8_BAR; PG8_MMA(1, 0, At, B0); PG8_MMA(1, 1, At, B1); PG8_BAR; PG8_SCHED;
            PG8_LDB(B0, 1, 0); PG8_LDB(B1, 1, 1); PG8_SCHED; PG8_LDA(At, 1, 0); PG8_STAGE_A(PG8_SA(0, 1), a2 + hstepA);
            PG8_WAIT_VH(8, 6); PG8_WAIT_L(0); PG8_BAR; PG8_MMA(0, 0, At, B0); PG8_MMA(0, 1, At, B1); PG8_BAR; PG8_SCHED;
            PG8_LDA(At, 1, 1); PG8_STAGE(PG8_SB(1, 0), b3, voffB); PG8_STAGE(PG8_SB(1, 1), b3 + hstepB, voffB); PG8_STAGE_A(PG8_SA(1, 0), a3);
            PG8_WAIT_VH(8, 6); PG8_WAIT_L(0); PG8_BAR; PG8_MMA(1, 0, At, B0); PG8_MMA(1, 1, At, B1); PG8_BAR; PG8_SCHED;
            } else {
            PG8_LDB(B0, 0, 0); PG8_SCHED; PG8_LDA(At, 0, 0); PG8_STAGE(PG8_SA(1, 1), a1 + hstepA, voffA);
            PG8_WAIT_L(8); PG8_BAR; PG8_WAIT_L(0); PG8_MMA(0, 0, At, B0); PG8_BAR; PG8_SCHED;
            PG8_LDB(B1, 0, 1); PG8_STAGE(PG8_SB(0, 0), b2, voffB);
            PG8_BAR; PG8_WAIT_L(0); PG8_MMA(0, 1, At, B1); PG8_BAR;
            PG8_LDA(At, 0, 1); PG8_STAGE(PG8_SA(0, 0), a2, voffA);
            PG8_BAR; PG8_WAIT_L(0); PG8_MMA(1, 0, At, B0); PG8_BAR; PG8_SCHED;
            PG8_STAGE(PG8_SB(0, 1), b2 + hstepB, voffB);
            PG8_WAIT_V(6); PG8_BAR; PG8_MMA(1, 1, At, B1); PG8_BAR;
            PG8_LDB(B0, 1, 0); PG8_SCHED; PG8_LDA(At, 1, 0); PG8_STAGE(PG8_SA(0, 1), a2 + hstepA, voffA);
            PG8_WAIT_L(8); PG8_BAR; PG8_WAIT_L(0); PG8_MMA(0, 0, At, B0); PG8_BAR; PG8_SCHED;
            PG8_LDB(B1, 1, 1); PG8_STAGE(PG8_SB(1, 0), b3, voffB);
            PG8_BAR; PG8_WAIT_L(0); PG8_MMA(0, 1, At, B1); PG8_BAR;
            PG8_LDA(At, 1, 1); PG8_STAGE(PG8_SA(1, 0), a3, voffA);
            PG8_BAR; PG8_WAIT_L(0); PG8_MMA(1, 0, At, B0); PG8_BAR; PG8_SCHED;
            PG8_STAGE(PG8_SB(1, 1), b3 + hstepB, voffB);
            PG8_WAIT_V(6); PG8_BAR; PG8_MMA(1, 1, At, B1); PG8_BAR;
            }
        }
        if constexpr (ALIGN_EPI) { if (wr == 0) PG8_BAR; }
        E(acc, cur, wr, wc, fr, fq);
        if (!has_next) break;
#pragma unroll
        for (int a = 0; a < 2; ++a)
#pragma unroll
            for (int b = 0; b < 2; ++b)
#pragma unroll
                for (int m = 0; m < MI; ++m)
#pragma unroll
                    for (int n = 0; n < 2; ++n) acc[a][b][m][n] = (f32x4){0.f, 0.f, 0.f, 0.f};
        cur = nxt; cA = nA; cB = nB; ++ui;
        if constexpr (ALIGN_EPI) { if (wr == 1) PG8_BAR; }
    }
    PG8_WAIT_V(0);
    if constexpr (!ALIGN_EPI) { if (wr == 0) PG8_BAR; }
    PG8_BAR;
#undef PG8_SA
#undef PG8_SB
#undef PG8_STAGE
#undef PG8_STAGE_A
#undef PG8_WAIT_VH
#undef PG8_LDA
#undef PG8_LDB
#undef PG8_MMA
#undef PG8_WAIT_V
#undef PG8_WAIT_L
#undef PG8_BAR
#undef PG8_SCHED
}
}

constexpr int NL = 4, DM = 2048, MTOK = 6144, MCTX = 4096, DIN_ = 6144, NGATE = 8192, NIG = 14336, DFF = 5632, NUP = 11264, KBR = 2560;
constexpr int N_ADA = 12288;
constexpr float EPS_ = 1e-6f;
constexpr size_t OUT_Y = 0, OUT_NK = (size_t)MTOK * DM, OUT_NV = OUT_NK + (size_t)16 * 4 * 256 * 1024;
constexpr size_t OUT_TOTAL = OUT_NV + (size_t)16 * 4 * 256 * 1024;

constexpr size_t al256(size_t x) { return (x + 255) & ~(size_t)255; }
constexpr size_t WS_CTL = 0, CTL_ZERO_BYTES = 1u << 20;
constexpr size_t WS_MOD = WS_CTL + CTL_ZERO_BYTES;
constexpr size_t WS_PARTMOD = al256(WS_MOD + (size_t)NL * 3 * N_ADA * 4);
constexpr size_t WS_LAM = al256(WS_PARTMOD + (size_t)NL * 32 * 3 * N_ADA * 4);
constexpr size_t WS_ROPE = al256(WS_LAM + 256);
constexpr size_t WS_TWC = al256(WS_ROPE + 64 * 32 * 2 * 4);
constexpr size_t WS_TW256 = al256(WS_TWC + 512 * 256 * 2);
constexpr size_t WS_TW1024 = al256(WS_TW256 + 256 * 512 * 2);
constexpr size_t WS_WIG = al256(WS_TW1024 + 1024 * 2048 * 2);
constexpr size_t SZ_WIG = (size_t)NIG * DM * 2;
constexpr size_t WS_WBR = al256(WS_WIG + NL * SZ_WIG);
constexpr size_t SZ_WBR = (size_t)DM * KBR * 2;
constexpr size_t WS_WO = al256(WS_WBR + NL * SZ_WBR);
constexpr size_t SZ_WO = (size_t)DM * DM * 2;
constexpr size_t WS_WUP = al256(WS_WO + NL * SZ_WO);
constexpr size_t SZ_WUP = (size_t)NUP * DM * 2;
constexpr size_t WS_WDN = al256(WS_WUP + NL * SZ_WUP);
constexpr size_t SZ_WDN = (size_t)DM * DFF * 2;
constexpr size_t WS_H = al256(WS_WDN + NL * SZ_WDN);
constexpr size_t WS_PROJ = al256(WS_H + (size_t)MTOK * DM * 2);
constexpr size_t WS_GATES = al256(WS_PROJ + (size_t)MTOK * DIN_ * 2);
constexpr size_t WS_KCTX = al256(WS_GATES + (size_t)MTOK * NGATE);
constexpr size_t WS_VCTX = al256(WS_KCTX + (size_t)MCTX * 1024 * 2);
constexpr size_t WS_KLAT = al256(WS_VCTX + (size_t)MCTX * 1024 * 2);
constexpr size_t SZ_KLAT = (size_t)2 * 1536 * 1024 * 2;
constexpr size_t WS_VLAT = al256(WS_KLAT + NL * SZ_KLAT);
constexpr size_t WS_AO = al256(WS_VLAT + NL * SZ_KLAT);
constexpr size_t WS_ML = al256(WS_AO + (size_t)2 * MTOK * 2048 * 2);
constexpr size_t WS_BR = al256(WS_ML + (size_t)2 * MTOK * 32 * 4);
constexpr size_t WS_PQC = al256(WS_BR + (size_t)MTOK * KBR * 2);
constexpr size_t WS_PQL = al256(WS_PQC + (size_t)16 * 512 * 512 * 2);
constexpr size_t WS_PART = al256(WS_PQL + (size_t)2 * 512 * 2048 * 2);
constexpr size_t WS_MERGED = al256(WS_PART + (size_t)3 * 192 * 32 * 512 * 8);
constexpr size_t WS_MIX = al256(WS_MERGED + (size_t)MTOK * DM * 2);
constexpr size_t WS_SSQ = al256(WS_MIX + (size_t)MTOK * DM * 4);
constexpr size_t WS_FACT = al256(WS_SSQ + (size_t)MTOK * 32 * 4);
constexpr size_t WS_FP = al256(WS_FACT + (size_t)MTOK * DFF * 2);
constexpr size_t WS_END = al256(WS_FP + (size_t)4 * 2048 * 512 * 4);

constexpr int CW_BAR = 4096;

constexpr int RING_BYTES = 131072;
constexpr int LDSCTL_OFF = RING_BYTES, MISC_OFF = LDSCTL_OFF + 320;
constexpr int LDS_BYTES = 147456;

namespace pg8 {
__constant__ unsigned char G1_PN[56] = {24, 25, 0, 8, 26, 27, 1, 28, 29, 2, 9, 30, 31, 3, 32, 33, 4, 10, 34, 35, 5, 36, 37, 6, 11, 38, 39, 7, 40, 41, 16, 12, 42, 43, 17, 44, 45, 18, 13, 46, 47, 19, 48, 49, 20, 14, 50, 51, 21, 52, 53, 22, 15, 54, 55, 23};
struct SchedMain {
    int nM, nN, G, c, nfull; const char* A; const char* B; size_t lda2, ldb2; const unsigned char* perm;
    __device__ __forceinline__ bool next(int i, Unit& u) const {
        const long L = (long)i * G + c; if (L >= nfull) return false;
        int pm, pn; tile_order(L, nM, nN, pm, pn); if (perm) pn = perm[pn];
        u.pm = pm; u.pn = pn; u.aux = 0; u.nt = 32; u.A = A + (size_t)pm * 256 * lda2; u.B = B + (size_t)pn * 256 * ldb2; return true;
    }
};
template <int MI> struct SchedLeft {
    static constexpr int NP = 4 / MI;
    int nM, nN, G, c, nfull; const char* A; const char* B; size_t lda2, ldb2; const unsigned char* perm;
    __device__ __forceinline__ bool next(int i, Unit& u) const {
        const int nunits = NP * (nM * nN - nfull); if (nunits <= 0) return false;
        long j; if (nunits <= G && G % nunits == 0) { const int st = G / nunits; if (i != 0 || c % st) return false; j = c / st; } else { j = (long)i * G + c; if (j >= nunits) return false; }
        int pm, pn; tile_order((long)nfull + j / NP, nM, nN, pm, pn); if (perm) pn = perm[pn]; const int q = (int)(j % NP);
        u.pm = pm * NP + q; u.pn = pn; u.aux = 0; u.nt = 32; u.A = A + (size_t)(pm * 256 + q * 64 * MI) * lda2; u.B = B + (size_t)pn * 256 * ldb2; return true;
    }
};
__device__ __forceinline__ unsigned pack_u8x4(float a, float b, float c, float d) {
    const unsigned ua = (unsigned)(a * 255.0f + 0.5f), ub = (unsigned)(b * 255.0f + 0.5f), uc = (unsigned)(c * 255.0f + 0.5f), ud = (unsigned)(d * 255.0f + 0.5f);
    return ua | (ub << 8) | (uc << 16) | (ud << 24);
}
template <int MI> struct EpiG1 {
    static constexpr bool PERM = true;
    static constexpr int TM = 64 * MI, TH = 32 * MI, TW = 16 * MI;
    bf16_t* proj; unsigned char* gates; bf16_t* kctx; bf16_t* vctx; bf16_t* klat; bf16_t* vlat; float* newk; float* newv; const float* bgate;
    __device__ __forceinline__ void operator()(const f32x4 (&acc)[2][2][MI][2], const Unit& u, int wr, int wc, int fr, int fq) const {
        const int pm = u.pm, pn = u.pn, cl0 = wc * 32 + 8 * fq;
        if (pn >= 24) {
            const int gc0 = (pn - 24) * 256 + cl0;
            f32x4 bv[2][2];
#pragma unroll
            for (int bj = 0; bj < 2; ++bj)
#pragma unroll
                for (int n = 0; n < 2; ++n) bv[bj][n] = *(const f32x4*)(bgate + gc0 + bj * HALF + 4 * n);
#pragma unroll
            for (int ai = 0; ai < 2; ++ai)
#pragma unroll
                for (int m = 0; m < MI; ++m) { unsigned char* rowp = gates + (size_t)(pm * TM + ai * TH + wr * TW + m * 16 + fr) * NGATE + gc0;
#pragma unroll
                    for (int bj = 0; bj < 2; ++bj) { const f32x4 v0 = acc[ai][bj][m][0] + bv[bj][0], v1 = acc[ai][bj][m][1] + bv[bj][1];
                        u32x2 w; w.x = pack_u8x4(sigmoid_f(v0[0]), sigmoid_f(v0[1]), sigmoid_f(v0[2]), sigmoid_f(v0[3])); w.y = pack_u8x4(sigmoid_f(v1[0]), sigmoid_f(v1[1]), sigmoid_f(v1[2]), sigmoid_f(v1[3]));
                        *(u32x2*)(rowp + bj * HALF) = w; } }
        } else if (pn >= 8 && pn < 16) {
            const bool isv = pn >= 12; const int c0 = (pn - (isv ? 12 : 8)) * 256 + cl0;
            const int r0 = pm * TM; bf16_t* base; float* ob = nullptr;
            if (r0 < MCTX) { base = (isv ? vctx : kctx) + (size_t)r0 * 1024; ob = (isv ? newv : newk) + ((size_t)(r0 >> 8) * 4 * 256 + (r0 & 255)) * 1024; }
            else { const int b = (r0 - MCTX) >> 10, t = (r0 - MCTX) & 1023; base = (isv ? vlat : klat) + (size_t)(b * 1536 + 512 + t) * 1024; }
#pragma unroll
            for (int ai = 0; ai < 2; ++ai)
#pragma unroll
                for (int m = 0; m < MI; ++m) { const size_t ro = (size_t)(ai * TH + wr * TW + m * 16 + fr) * 1024 + c0;
#pragma unroll
                    for (int bj = 0; bj < 2; ++bj) { const f32x4 v0 = acc[ai][bj][m][0], v1 = acc[ai][bj][m][1];
                        u32x4 w; w.x = cvt_pk_bf16(v0[0], v0[1]); w.y = cvt_pk_bf16(v0[2], v0[3]); w.z = cvt_pk_bf16(v1[0], v1[1]); w.w = cvt_pk_bf16(v1[2], v1[3]);
                        *(u32x4*)(base + ro + bj * HALF) = w;
                        if (ob) { *(f32x4*)(ob + ro + bj * HALF) = v0; *(f32x4*)(ob + ro + bj * HALF + 4) = v1; } } }
        } else {
#pragma unroll
            for (int ai = 0; ai < 2; ++ai)
#pragma unroll
                for (int m = 0; m < MI; ++m) { bf16_t* rowp = proj + (size_t)(pm * TM + ai * TH + wr * TW + m * 16 + fr) * DIN_ + pn * 256 + cl0;
#pragma unroll
                    for (int bj = 0; bj < 2; ++bj) { const f32x4 v0 = acc[ai][bj][m][0], v1 = acc[ai][bj][m][1];
                        u32x4 w; w.x = cvt_pk_bf16(v0[0], v0[1]); w.y = cvt_pk_bf16(v0[2], v0[3]); w.z = cvt_pk_bf16(v1[0], v1[1]); w.w = cvt_pk_bf16(v1[2], v1[3]);
                        *(u32x4*)(rowp + bj * HALF) = w; } }
        }
    }
};
struct EpiBf16 {
    static constexpr bool PERM = true;
    bf16_t* O; int ldc; int coloff;
    __device__ __forceinline__ void operator()(const f32x4 (&acc)[2][2][4][2], const Unit& u, int wr, int wc, int fr, int fq) const {
#pragma unroll
        for (int ai = 0; ai < 2; ++ai)
#pragma unroll
            for (int m = 0; m < 4; ++m) { bf16_t* rowp = O + (size_t)(u.pm * 256 + ai * HALF + m * 16 + wr * 64 + fr) * ldc + coloff + u.pn * 256 + wc * 32 + 8 * fq;
#pragma unroll
                for (int bj = 0; bj < 2; ++bj) { const f32x4 v0 = acc[ai][bj][m][0], v1 = acc[ai][bj][m][1];
                    u32x4 w; w.x = cvt_pk_bf16(v0[0], v0[1]); w.y = cvt_pk_bf16(v0[2], v0[3]); w.z = cvt_pk_bf16(v1[0], v1[1]); w.w = cvt_pk_bf16(v1[2], v1[3]);
                    *(u32x4*)(rowp + bj * HALF) = w; } }
    }
};
struct EpiF1 {
    static constexpr bool PERM = true;
    bf16_t* pqc; bf16_t* pql;
    __device__ __forceinline__ void operator()(const f32x4 (&acc)[2][2][4][2], const Unit& u, int wr, int wc, int fr, int fq) const {
        const int g = 2 * u.aux + u.pm, pn = u.pn; bf16_t* base; int T, tl0;
        if (pn < 16) { base = pqc + (size_t)pn * 512 * 512; T = 256; tl0 = 0; } else { base = pql + (size_t)((pn - 16) >> 2) * 512 * 2048; T = 1024; tl0 = ((pn - 16) & 3) * 256; }
#pragma unroll
        for (int ai = 0; ai < 2; ++ai)
#pragma unroll
            for (int m = 0; m < 4; ++m) { const int j = wr * 64 + m * 16 + fr; bf16_t* rowp = base + (size_t)(g * 128 + j) * (2 * T) + ai * T + tl0 + wc * 32 + 8 * fq;
#pragma unroll
                for (int bj = 0; bj < 2; ++bj) { const f32x4 v0 = acc[ai][bj][m][0], v1 = acc[ai][bj][m][1];
                    u32x4 w; w.x = cvt_pk_bf16(v0[0], v0[1]); w.y = cvt_pk_bf16(v0[2], v0[3]); w.z = cvt_pk_bf16(v1[0], v1[1]); w.w = cvt_pk_bf16(v1[2], v1[3]);
                    *(u32x4*)(rowp + bj * HALF) = w; } }
    }
};
template <int MI> struct EpiG2 {
    static constexpr bool PERM = false;
    const unsigned char* gates; unsigned* part; bf16_t* merged;
    static constexpr int TM = 64 * MI, TH = 32 * MI, TW = 16 * MI, NFR = 8 * MI; static constexpr size_t SLAB = (size_t)(MTOK / TM) * 8 * NFR * 512 * 2;
    __device__ __forceinline__ void operator()(const f32x4 (&acc)[2][2][MI][2], const Unit& u, int wr, int wc, int fr, int fq) const {
        const int i = u.aux, tile = u.pm * 8 + u.pn, tid = (wr * 4 + wc) * 64 + fq * 16 + fr;
        unsigned* pb = part + ((size_t)tile * NFR * 512 + tid) * 2;
#pragma unroll
        for (int ai = 0; ai < 2; ++ai) {
            unsigned gw[MI][2][2];
#pragma unroll
            for (int m = 0; m < MI; ++m) { const unsigned char* gp = gates + (size_t)(u.pm * TM + ai * TH + m * 16 + wr * TW + fr) * NGATE + i * 2048 + u.pn * 256 + wc * 32 + 4 * fq;
#pragma unroll
                for (int bj = 0; bj < 2; ++bj)
#pragma unroll
                    for (int n = 0; n < 2; ++n) gw[m][bj][n] = *(const unsigned*)(gp + bj * HALF + n * 16); }
#pragma unroll
            for (int m = 0; m < MI; ++m) { const size_t row = (size_t)(u.pm * TM + ai * TH + m * 16 + wr * TW + fr);
                u32x2 z[3][2][2];
                if (i == 3) {
#pragma unroll
                    for (int bj = 0; bj < 2; ++bj)
#pragma unroll
                        for (int n = 0; n < 2; ++n) { const unsigned* p = pb + (size_t)((((ai * MI + m) * 2 + bj) * 2 + n) * 512) * 2;
                            z[0][bj][n] = *(const u32x2*)p; z[1][bj][n] = *(const u32x2*)(p + SLAB); z[2][bj][n] = *(const u32x2*)(p + 2 * SLAB); }
                }
#pragma unroll
                for (int bj = 0; bj < 2; ++bj)
#pragma unroll
                    for (int n = 0; n < 2; ++n) { const int col = u.pn * 256 + bj * HALF + wc * 32 + n * 16 + 4 * fq;
                        f32x4 v = acc[ai][bj][m][n]; const unsigned g = gw[m][bj][n]; constexpr float K255 = 1.0f / 255.0f;
                        v[0] *= (float)(g & 255u) * K255; v[1] *= (float)((g >> 8) & 255u) * K255; v[2] *= (float)((g >> 16) & 255u) * K255; v[3] *= (float)(g >> 24) * K255;
                        unsigned* p = pb + (size_t)((((ai * MI + m) * 2 + bj) * 2 + n) * 512) * 2;
                        if (i == 3) {
#pragma unroll
                            for (int k = 0; k < 3; ++k) { const u32x2 zz = z[k][bj][n]; v[0] += bf_lo(zz.x); v[1] += bf_hi(zz.x); v[2] += bf_lo(zz.y); v[3] += bf_hi(zz.y); }
                            u32x2 w; w.x = cvt_pk_bf16(v[0], v[1]); w.y = cvt_pk_bf16(v[2], v[3]); *(u32x2*)(merged + row * DM + col) = w; }
                        else { u32x2 w; w.x = cvt_pk_bf16(v[0], v[1]); w.y = cvt_pk_bf16(v[2], v[3]); *(u32x2*)(p + (size_t)i * SLAB) = w; } } }
        }
    }
};
template <int MI> struct EpiSsq {
    static constexpr bool PERM = false;
    float* out; float* ssq;
    __device__ __forceinline__ void operator()(const f32x4 (&acc)[2][2][MI][2], const Unit& u, int wr, int wc, int fr, int fq) const {
#pragma unroll
        for (int ai = 0; ai < 2; ++ai)
#pragma unroll
            for (int m = 0; m < MI; ++m) { const size_t row = (size_t)(u.pm * (64 * MI) + ai * (32 * MI) + m * 16 + wr * (16 * MI) + fr); float s = 0.f;
#pragma unroll
                for (int bj = 0; bj < 2; ++bj)
#pragma unroll
                    for (int n = 0; n < 2; ++n) { const int col = u.pn * 256 + bj * HALF + wc * 32 + n * 16 + 4 * fq; const f32x4 v = acc[ai][bj][m][n];
                        *(f32x4*)(out + row * DM + col) = v; s += (v[0] * v[0] + v[1] * v[1]) + (v[2] * v[2] + v[3] * v[3]); }
                s += __shfl_xor(s, 16); s += __shfl_xor(s, 32);
                if (fq == 0) ssq[((size_t)u.pn * MTOK + row) * 4 + wc] = s; }
    }
};
template <int MI> struct EpiSwiGLU {
    static constexpr bool PERM = false;
    bf16_t* fact;
    __device__ __forceinline__ void operator()(const f32x4 (&acc)[2][2][MI][2], const Unit& u, int wr, int wc, int fr, int fq) const {
#pragma unroll
        for (int ai = 0; ai < 2; ++ai)
#pragma unroll
            for (int m = 0; m < MI; ++m) { const size_t row = (size_t)(u.pm * (64 * MI) + ai * (32 * MI) + m * 16 + wr * (16 * MI) + fr);
#pragma unroll
                for (int bj = 0; bj < 2; ++bj) { const f32x4 up = acc[ai][bj][m][0], gt = acc[ai][bj][m][1]; const int j = u.pn * 128 + (4 * bj + wc) * 16 + 4 * fq;
                    u32x2 w; w.x = cvt_pk_bf16(gt[0] * sigmoid_f(gt[0]) * up[0], gt[1] * sigmoid_f(gt[1]) * up[1]); w.y = cvt_pk_bf16(gt[2] * sigmoid_f(gt[2]) * up[2], gt[3] * sigmoid_f(gt[3]) * up[3]);
                    *(u32x2*)(fact + row * DFF + j) = w; } }
    }
};
template <int MI> struct SchedG2 {
    int G, c; const char* A; const char* B;
    __device__ __forceinline__ bool next(int i, Unit& u) const {
        int pm, pn; if (!tile_order((long)(i >> 2) * G + c, MTOK / (64 * MI), 8, pm, pn)) return false;
        const int br = i & 3, koff = br == 0 ? 0 : (br == 1 ? 512 : (br == 2 ? 1536 : 2048));
        u.pm = pm; u.pn = pn; u.aux = br; u.nt = br == 1 ? 16 : 8;
        u.A = A + ((size_t)pm * (64 * MI) * KBR + koff) * 2; u.B = B + ((size_t)pn * 256 * KBR + koff) * 2; return true;
    }
};
struct SchedF1 {
    int G, c, nt; const char* A; const char* B;
    __device__ __forceinline__ bool next(int i, Unit& u) const {
        const int L = i * G + c; if (L >= 96) return false;
        const int p = L / 48, r = L % 48; u.pm = r & 1; u.pn = r >> 1; u.aux = p; u.nt = nt;
        u.A = A + (size_t)u.pm * 256 * 256 * 2; u.B = B + ((size_t)(u.pn * 256) * DIN_ + 5632 + p * 256) * 2; return true;
    }
};
struct SchedF2L {
    int G, c; const char* A; const char* B;
    __device__ __forceinline__ bool next(int i, Unit& u) const {
        const int L = i * G + c; if (L >= 64) return false;
        const int ks = L & 3, t = L >> 2, b = t >> 3, pm = (t >> 1) & 3, pn = t & 1; u.pm = b * 4 + pm; u.pn = pn; u.aux = ks; u.nt = 8;
        u.A = A + ((size_t)pm * 256 * 2048 + ks * 512) * 2; u.B = B + ((size_t)b * 512 * 2048 + (size_t)pn * 256 * 2048 + ks * 512) * 2; return true;
    }
};
struct EpiF2P {
    static constexpr bool PERM = false;
    float* fp;
    __device__ __forceinline__ void operator()(const f32x4 (&acc)[2][2][4][2], const Unit& u, int wr, int wc, int fr, int fq) const {
        float* base = fp + (size_t)u.aux * 2048 * 512;
#pragma unroll
        for (int ai = 0; ai < 2; ++ai)
#pragma unroll
            for (int m = 0; m < 4; ++m) { float* rowp = base + (size_t)(u.pm * 256 + ai * HALF + m * 16 + wr * 64 + fr) * 512 + u.pn * 256 + wc * 32 + 4 * fq;
#pragma unroll
                for (int bj = 0; bj < 2; ++bj)
#pragma unroll
                    for (int n = 0; n < 2; ++n) *(f32x4*)(rowp + bj * HALF + n * 16) = acc[ai][bj][m][n]; }
    }
};
struct SchedF2C {
    int G, c; const char* A; const char* B;
    __device__ __forceinline__ bool next(int i, Unit& u) const {
        const int idx = i * G + (c + G - (64 % G)) % G; if (idx >= 32) return false;
        const int s = idx >> 1, pn = idx & 1; u.pm = s; u.pn = pn; u.aux = 0; u.nt = 8;
        u.A = A; u.B = B + ((size_t)s * 512 * 512 + (size_t)pn * 256 * 512) * 2; return true;
    }
};
}

namespace att {
constexpr int D = 128, NW = 8, QBLK = 32, KVBLK = 64;
constexpr float SCALE = 0.088388347648318440f;
constexpr float THR = 8.f;
constexpr int LDQ = 6144, LDK = 1024, LDO = 2048;
constexpr size_t SHM_V = KVBLK * D * 2, SHM_K = KVBLK * D * 2, SHM_ATTN = 2 * SHM_V + 2 * SHM_K + NW * 64 * 4;
#define KSWZ(row, colB) ((row) * 256 + ((colB) ^ (((row) & 7) << 4)))
#define SBAR() __builtin_amdgcn_sched_barrier(0)
__device__ __forceinline__ int crow(int r, int hi) { return (r & 3) + 8 * (r >> 2) + 4 * hi; }
__device__ __forceinline__ unsigned cvtpk(float lo, float hi) { return cvt_pk_bf16_c(lo, hi); }

__device__ __forceinline__ void partialSM(f32x16& p0, f32x16& p1, float& m_reg, float& mn, float& alpha) {
  constexpr float C = SCALE * 1.4426950408889634f;
  float pmax = p0[0];
#pragma unroll
  for (int r = 1; r < 16; ++r) pmax = fmaxf(pmax, p0[r]);
#pragma unroll
  for (int r = 0; r < 16; ++r) pmax = fmaxf(pmax, p1[r]);
  { auto rr = __builtin_amdgcn_permlane32_swap(__float_as_uint(pmax), __float_as_uint(pmax), false, false);
    pmax = fmaxf(__uint_as_float(rr[0]), __uint_as_float(rr[1])); }
  if (__builtin_expect(__all(pmax - m_reg <= THR / SCALE), 1)) { mn = m_reg; alpha = 1.f; }
  else { mn = fmaxf(m_reg, pmax); alpha = __builtin_amdgcn_exp2f((m_reg - mn) * C); m_reg = mn; }
  float mnC = -mn * C;
#pragma unroll
  for (int r = 0; r < 16; ++r) p0[r] = fmaf(p0[r], C, mnC);
#pragma unroll
  for (int r = 0; r < 16; ++r) p1[r] = fmaf(p1[r], C, mnC);
#pragma unroll
  for (int r = 0; r < 16; ++r) p0[r] = __builtin_amdgcn_exp2f(p0[r]);
}
__device__ __forceinline__ void finishSM(f32x16& p0, f32x16& p1, float alpha, float& l_reg, bf16x8& pa0, bf16x8& pa1, bf16x8& pa2, bf16x8& pa3) {
#pragma unroll
  for (int r = 0; r < 16; ++r) p1[r] = __builtin_amdgcn_exp2f(p1[r]);
  float ps = 0;
#pragma unroll
  for (int r = 0; r < 16; ++r) ps += p0[r];
#pragma unroll
  for (int r = 0; r < 16; ++r) ps += p1[r];
  { auto rr = __builtin_amdgcn_permlane32_swap(__float_as_uint(ps), __float_as_uint(ps), false, false);
    ps = __uint_as_float(rr[0]) + __uint_as_float(rr[1]); }
  l_reg = l_reg * alpha + ps;
#define PK4(P, BASE, OUT) do { unsigned a0 = cvtpk(P[BASE + 0], P[BASE + 1]), a1 = cvtpk(P[BASE + 2], P[BASE + 3]);   \
    unsigned b0 = cvtpk(P[BASE + 4], P[BASE + 5]), b1 = cvtpk(P[BASE + 6], P[BASE + 7]);                              \
    auto r0 = __builtin_amdgcn_permlane32_swap(a0, b0, false, false); auto r1 = __builtin_amdgcn_permlane32_swap(a1, b1, false, false); \
    v4u w = {r0[0], r1[0], r0[1], r1[1]}; OUT = __builtin_bit_cast(bf16x8, w); } while (0)
  PK4(p0, 0, pa0); PK4(p0, 8, pa1); PK4(p1, 0, pa2); PK4(p1, 8, pa3);
#undef PK4
}
__device__ __forceinline__ void qkt(f32x16& p0, f32x16& p1, const LAS char* Ks, const bf16x8* qr, int r32, int hi) {
  p0 = f32x16{}; p1 = f32x16{};
#pragma unroll
  for (int d0 = 0; d0 < 8; ++d0) { int cb = (d0 * 16 + hi * 8) * 2;
    bf16x8 b0 = *(const LAS bf16x8*)(Ks + KSWZ(r32, cb));
    bf16x8 b1 = *(const LAS bf16x8*)(Ks + KSWZ(32 + r32, cb));
    p0 = __builtin_amdgcn_mfma_f32_32x32x16_bf16(b0, qr[d0], p0, 0, 0, 0);
    p1 = __builtin_amdgcn_mfma_f32_32x32x16_bf16(b1, qr[d0], p1, 0, 0, 0); }
}
__device__ __forceinline__ int v_st(int k, int c) { const int kk = (k & ~0xC) | ((k & 4) << 1) | ((k & 8) >> 1); return ((kk >> 3) * 4 + (c >> 5)) * 512 + ((kk & 7) * 32 + (c & 31)) * 2; }
__device__ __forceinline__ int v_rd_base(int lane) { return ((lane & 3) << 3) | (((lane >> 2) & 3) << 6) | (((lane >> 4) & 1) << 5) | (((lane >> 5) & 1) << 8); }
constexpr int v_rd_off(int d0, int ks, int half) { return d0 * 512 + ks * 4096 + half * 2048; }
template <int OFF> __device__ __forceinline__ s16x4 tr_read(int vb) {
  s16x4 r; asm volatile("ds_read_b64_tr_b16 %0, %1 offset:%2" : "=&v"(r) : "v"(vb), "i"(OFF) : "memory"); return r;
}
template <int D0> __device__ __forceinline__ void pv_one(f32x16& od, int vb, bf16x8 pa0, bf16x8 pa1, bf16x8 pa2, bf16x8 pa3) {
  const s16x4 l0 = tr_read<v_rd_off(D0, 0, 0)>(vb), h0 = tr_read<v_rd_off(D0, 0, 1)>(vb), l1 = tr_read<v_rd_off(D0, 1, 0)>(vb), h1 = tr_read<v_rd_off(D0, 1, 1)>(vb);
  const s16x4 l2 = tr_read<v_rd_off(D0, 2, 0)>(vb), h2 = tr_read<v_rd_off(D0, 2, 1)>(vb), l3 = tr_read<v_rd_off(D0, 3, 0)>(vb), h3 = tr_read<v_rd_off(D0, 3, 1)>(vb);
  asm volatile("s_waitcnt lgkmcnt(0)" ::: "memory"); SBAR();
#define PK(L, H) (bf16x8){L[0], L[1], L[2], L[3], H[0], H[1], H[2], H[3]}
  od = __builtin_amdgcn_mfma_f32_32x32x16_bf16(pa0, PK(l0, h0), od, 0, 0, 0);
  od = __builtin_amdgcn_mfma_f32_32x32x16_bf16(pa1, PK(l1, h1), od, 0, 0, 0);
  od = __builtin_amdgcn_mfma_f32_32x32x16_bf16(pa2, PK(l2, h2), od, 0, 0, 0);
  od = __builtin_amdgcn_mfma_f32_32x32x16_bf16(pa3, PK(l3, h3), od, 0, 0, 0);
#undef PK
}
__device__ __forceinline__ void pv_d0(f32x16* o, int vb, bf16x8 pa0, bf16x8 pa1, bf16x8 pa2, bf16x8 pa3) {
  pv_one<0>(o[0], vb, pa0, pa1, pa2, pa3); pv_one<1>(o[1], vb, pa0, pa1, pa2, pa3); pv_one<2>(o[2], vb, pa0, pa1, pa2, pa3); pv_one<3>(o[3], vb, pa0, pa1, pa2, pa3);
}

__device__ __forceinline__ void attn_unit(const bf16* __restrict__ Qb, const bf16* __restrict__ Kh, const bf16* __restrict__ Vh,
                                          bf16* __restrict__ Ob, float* __restrict__ MLb, int seq, LAS char* lds, const int tid) {
  const int wid = tid >> 6, lane = tid & 63, r32 = lane & 31, hi = lane >> 5;
  LAS char* V_lds = lds; LAS char* K_lds = lds + 2 * SHM_V;
  LAS float* wsf = (LAS float*)(lds + 2 * SHM_V + 2 * SHM_K) + wid * 64; LAS float* al_l = wsf + 32;
  float m_reg = -1e30f, l_reg = 0; f32x16 o[4] = {}; bf16x8 qr[8];
  const int qoff = (wid * QBLK + r32) * LDQ + hi * 8;
#pragma unroll
  for (int d0 = 0; d0 < 8; ++d0) qr[d0] = *(const bf16x8*)(Qb + qoff + d0 * 16);
  const int sr = tid >> 4, sc = (tid & 15) * 8, vst0 = v_st(sr, sc), vst1 = v_st(32 + sr, sc);
  const int vb0 = (int)(unsigned)(uintptr_t)V_lds + v_rd_base(lane);
  const int kvoff = sr * LDK + sc;
  struct { bf16x8 vs0, vs1, ks0, ks1; } sr_[2];
#define SLOAD(i, k0) do { const bf16* Vt_ = Vh + (size_t)(k0) * LDK; const bf16* Kt_ = Kh + (size_t)(k0) * LDK; \
    sr_[i].vs0 = *(const bf16x8*)(Vt_ + kvoff); sr_[i].vs1 = *(const bf16x8*)(Vt_ + 32 * LDK + kvoff); \
    sr_[i].ks0 = *(const bf16x8*)(Kt_ + kvoff); sr_[i].ks1 = *(const bf16x8*)(Kt_ + 32 * LDK + kvoff); } while (0)
#define SWRITE(b, i) do { *(LAS bf16x8*)(V_lds + (b) * SHM_V + vst0) = sr_[i].vs0;          \
    *(LAS bf16x8*)(V_lds + (b) * SHM_V + vst1) = sr_[i].vs1; int kc = sc * 2;               \
    *(LAS bf16x8*)(K_lds + (b) * SHM_K + KSWZ(sr, kc)) = sr_[i].ks0;                       \
    *(LAS bf16x8*)(K_lds + (b) * SHM_K + KSWZ(32 + sr, kc)) = sr_[i].ks1; } while (0)
#define SWAIT() asm volatile("s_waitcnt vmcnt(4)" ::: "memory")
#define RESC(a) do { if (__any((a) < 1.f)) { if (hi == 0) al_l[r32] = (a); asm volatile("s_waitcnt lgkmcnt(0)" ::: "memory"); \
    _Pragma("unroll") for (int d = 0; d < 4; ++d) _Pragma("unroll") for (int r = 0; r < 16; ++r) o[d][r] *= al_l[crow(r, hi)]; } } while (0)
  f32x16 pA0, pA1, pB0, pB1; float mnA, mnB, alA, alB; bf16x8 pa0, pa1, pa2, pa3; const int NT = seq / KVBLK;
  constexpr int SE = 0, SO = 1;
  SLOAD(SE, 0); asm volatile("s_waitcnt vmcnt(0)" ::: "memory"); SWRITE(0, SE); __syncthreads();
  qkt(pA0, pA1, K_lds, qr, r32, hi); partialSM(pA0, pA1, m_reg, mnA, alA);
  SLOAD(SO, KVBLK); if (2 < NT) SLOAD(SE, 2 * KVBLK);
  SWAIT(); SWRITE(1, SO); __syncthreads();
  for (int j = 1; j + 1 < NT; j += 2) {
    SBAR(); qkt(pB0, pB1, K_lds + SHM_K, qr, r32, hi);
    finishSM(pA0, pA1, alA, l_reg, pa0, pa1, pa2, pa3); SBAR();
    SLOAD(SO, (j + 2) * KVBLK); SBAR();
    pv_d0(o, vb0, pa0, pa1, pa2, pa3); partialSM(pB0, pB1, m_reg, mnB, alB);
    __syncthreads(); SWAIT(); SWRITE(0, SE);
    RESC(alB); __syncthreads();
    SBAR(); qkt(pA0, pA1, K_lds, qr, r32, hi);
    finishSM(pB0, pB1, alB, l_reg, pa0, pa1, pa2, pa3); SBAR();
    if (j + 3 < NT) SLOAD(SE, (j + 3) * KVBLK); SBAR();
    pv_d0(o, vb0 + (int)SHM_V, pa0, pa1, pa2, pa3); partialSM(pA0, pA1, m_reg, mnA, alA);
    __syncthreads(); SWAIT(); SWRITE(1, SO);
    RESC(alA); __syncthreads();
  }
  SBAR(); qkt(pB0, pB1, K_lds + SHM_K, qr, r32, hi);
  finishSM(pA0, pA1, alA, l_reg, pa0, pa1, pa2, pa3); SBAR();
  pv_d0(o, vb0, pa0, pa1, pa2, pa3); partialSM(pB0, pB1, m_reg, mnB, alB);
  __syncthreads(); RESC(alB);
  finishSM(pB0, pB1, alB, l_reg, pa0, pa1, pa2, pa3); SBAR();
  pv_d0(o, vb0 + (int)SHM_V, pa0, pa1, pa2, pa3);
  const int ooff = (wid * QBLK + 4 * hi) * LDO + r32;
#pragma unroll
  for (int r = 0; r < 16; ++r) {
#pragma unroll
    for (int d0 = 0; d0 < 4; ++d0) Ob[ooff + ((r & 3) + 8 * (r >> 2)) * LDO + d0 * 32] = (bf16)f2bf(o[d0][r]); }
  if (hi == 0) { const int mo = (wid * QBLK + r32) * 2; MLb[mo] = m_reg; MLb[mo + 1] = l_reg; }
  __syncthreads();
#undef SLOAD
#undef SWRITE
#undef SWAIT
#undef RESC
}
#undef KSWZ
#undef SBAR
}
#define XB_TMO      128
#define XB_XCNT(j)  (256  + 64 * (j))
#define XB_XSUB(j)  (1280 + 64 * (j))
#define XB_XGEN(j)  (2304 + 64 * (j))
#define XB_TOP      3328
#define XB_TOPGEN   3392
#define XCD_BAR_WORDS 3456
#define XB_SPIN_CAP (1u << 18)

__device__ __forceinline__ unsigned xb_ld(unsigned* p)              { return __hip_atomic_load(p, __ATOMIC_RELAXED, __HIP_MEMORY_SCOPE_AGENT); }
__device__ __forceinline__ unsigned xb_add(unsigned* p, unsigned v) { return __hip_atomic_fetch_add(p, v, __ATOMIC_RELAXED, __HIP_MEMORY_SCOPE_AGENT); }
__device__ __forceinline__ unsigned xb_xcc_id() { return (unsigned)__builtin_amdgcn_s_getreg((3 << 11) | 20) & 0xFu; }
#define XB_SPIN(cond, bar) do { unsigned _sp = 0; while (cond) { __builtin_amdgcn_s_sleep(1); \
    if ((++_sp & 255u) == 0u) { if (xb_ld(&(bar)[XB_TMO])) break; if (_sp > XB_SPIN_CAP) { atomicAdd(&(bar)[XB_TMO], 1u); break; } } } } while (0)

struct XcdBarrier {
    unsigned* bar; unsigned x;
    volatile LAS unsigned* st;
};

__device__ __forceinline__ XcdBarrier xcd_barrier_post(unsigned* bar, volatile LAS unsigned* st) {
    XcdBarrier b; b.bar = bar; b.x = xb_xcc_id(); b.st = st;
    if (threadIdx.x == 0) (void)xb_add(&bar[XB_XCNT(b.x)], 1u);
    return b;
}
__device__ __forceinline__ void xcd_barrier_complete(unsigned* bar, unsigned x, unsigned& nloc, unsigned& nx) {
    const unsigned G = gridDim.x * gridDim.y * gridDim.z;
    unsigned sum, cnt, mine, sp = 0u;
    for (;;) {
        sum = 0u; cnt = 0u; mine = 0u;
#pragma unroll
        for (unsigned j = 0; j < 16; ++j) { const unsigned c = xb_ld(&bar[XB_XCNT(j)]); sum += c; cnt += (c > 0u) ? 1u : 0u; mine = (j == x) ? c : mine; }
        if (sum == G) break;
        __builtin_amdgcn_s_sleep(1);
        if ((++sp & 255u) == 0u) { if (xb_ld(&bar[XB_TMO])) break; if (sp > XB_SPIN_CAP) { atomicAdd(&bar[XB_TMO], 1u); break; } }
    }
    nloc = mine > 0u ? mine : 1u; nx = cnt > 0u ? cnt : 1u;
}

__device__ __forceinline__ void xcd_barrier(const XcdBarrier& b) {
    asm volatile("s_waitcnt vmcnt(0)" ::: "memory");
    __syncthreads();
    if (threadIdx.x == 0) {
        unsigned* bar = b.bar;
        __builtin_amdgcn_s_waitcnt(0);
        unsigned nloc = b.st[0], nx = b.st[1];
        if (nloc == 0u) { xcd_barrier_complete(bar, b.x, nloc, nx); b.st[0] = nloc; b.st[1] = nx; }
        const unsigned old = xb_add(&bar[XB_XSUB(b.x)], 1u);
        const unsigned gen = old / nloc;
        if (old + 1u == (gen + 1u) * nloc) {
            __builtin_amdgcn_fence(__ATOMIC_RELEASE, "agent");
            asm volatile("s_waitcnt vmcnt(0)" ::: "memory");
            const unsigned og = xb_add(&bar[XB_TOP], 1u);
            const unsigned tg = og / nx;
            if (og + 1u == (tg + 1u) * nx) xb_add(&bar[XB_TOPGEN], 1u);
            else XB_SPIN(xb_ld(&bar[XB_TOPGEN]) == tg, bar);
            __builtin_amdgcn_fence(__ATOMIC_ACQUIRE, "agent");
            xb_add(&bar[XB_XGEN(b.x)], 1u);
            asm volatile("s_waitcnt vmcnt(0)" ::: "memory");
        } else {
            XB_SPIN(xb_ld(&bar[XB_XGEN(b.x)]) == gen, bar);
            __builtin_amdgcn_fence(__ATOMIC_ACQUIRE, "agent");
            asm volatile("s_waitcnt vmcnt(0)" ::: "memory");
        }
    }
    __syncthreads();
}

struct Params { const float* in[32]; float* out; unsigned char* ws; };

__device__ __forceinline__ void transpose_item(const float* W, int N, bf16* WT, int ldw, int koff, int rowoff, int upmode, LAS float* scr, int item, int lane) {
    const int nblk = N / 32, kb = item / nblk, nb = item % nblk, k0 = 64 * kb, n0 = 32 * nb;
#pragma unroll
    for (int i = 0; i < 32; ++i) { const int kk = 2 * i + (lane >> 5); scr[kk * 33 + (lane & 31)] = __builtin_nontemporal_load(&W[(size_t)(k0 + kk) * N + n0 + (lane & 31)]); }
    LDS_WAIT(); asm volatile("" ::: "memory");
    const int c = lane & 7;
#pragma unroll
    for (int j = 0; j < 4; ++j) { const int n = (lane >> 3) + 8 * j; const LAS float* s = scr + (8 * c) * 33 + n;
        v4u o; o.x = pk2(s[0 * 33], s[1 * 33]); o.y = pk2(s[2 * 33], s[3 * 33]); o.z = pk2(s[4 * 33], s[5 * 33]); o.w = pk2(s[6 * 33], s[7 * 33]);
        const int nn = n0 + n; int row;
        if (upmode) { const int isgt = nn >= DFF ? 1 : 0; const int jj = nn - isgt * DFF; row = (jj >> 7) * 256 + ((jj & 127) >> 4) * 32 + isgt * 16 + (jj & 15); }
        else row = rowoff + nn;
        __builtin_nontemporal_store(o, (GAS v4u*)(WT + (size_t)row * ldw + koff + k0 + 8 * c)); }
    LDS_WAIT(); asm volatile("" ::: "memory");
}

template <bool HAS_ADD>
__device__ __forceinline__ void row_phase(int vcu, int G, int tid, LAS float* lv, const float* xin_ctx, const float* xin_lat, float* X, const float* add, const float* ssq,
                                          const float* modg, const float* gpost, bool has_norm, const float* gnext, const float* modsc, const float* modsh, bf16* H) {
    const int lane = tid & 63, wave = __builtin_amdgcn_readfirstlane(tid >> 6), NGW = G * 8; int vcur = -1;
    for (int base = vcu * 8; base < MTOK; base += NGW) {
        const int row = base + wave, v = base < MCTX ? 0 : 1 + ((base - MCTX) >> 10);
        if (v != vcur) {
            __syncthreads();
            const int c4 = 4 * tid; const size_t vo = (size_t)v * N_ADA + c4;
            if constexpr (HAS_ADD) *(LAS f32x4*)(lv + c4) = *(const f32x4*)(modg + vo) * *(const f32x4*)(gpost + c4);
            if (has_norm) { *(LAS f32x4*)(lv + 2048 + c4) = *(const f32x4*)(gnext + c4) * (*(const f32x4*)(modsc + vo) + 1.0f); *(LAS f32x4*)(lv + 4096 + c4) = *(const f32x4*)(modsh + vo); }
            __syncthreads(); vcur = v;
        }
        const float* xr = row < MCTX ? xin_ctx + (size_t)row * DM : xin_lat + (size_t)(row - MCTX) * DM;
        f32x4 x[8];
#pragma unroll
        for (int j = 0; j < 8; ++j) x[j] = *(const f32x4*)(xr + 4 * lane + 256 * j);
        if constexpr (HAS_ADD) {
            const float* ar = add + (size_t)row * DM; f32x4 a[8];
#pragma unroll
            for (int j = 0; j < 8; ++j) a[j] = *(const f32x4*)(ar + 4 * lane + 256 * j);
            float sp = lane < 32 ? ssq[((size_t)(lane >> 2) * MTOK + row) * 4 + (lane & 3)] : 0.f;
            const float rs = __builtin_amdgcn_rsqf(wave_sum(sp) * (1.0f / DM) + EPS_);
#pragma unroll
            for (int j = 0; j < 8; ++j) x[j] = x[j] + *(const LAS f32x4*)(lv + 4 * lane + 256 * j) * (a[j] * rs);
        }
        float* xo = X + (size_t)row * DM;
#pragma unroll
        for (int j = 0; j < 8; ++j) *(f32x4*)(xo + 4 * lane + 256 * j) = x[j];
        if (has_norm) {
            float s2 = 0.f;
#pragma unroll
            for (int j = 0; j < 8; ++j) s2 += (x[j][0] * x[j][0] + x[j][1] * x[j][1]) + (x[j][2] * x[j][2] + x[j][3] * x[j][3]);
            const float r2 = __builtin_amdgcn_rsqf(wave_sum(s2) * (1.0f / DM) + EPS_);
            bf16* ho = H + (size_t)row * DM;
#pragma unroll
            for (int j = 0; j < 8; ++j) { const int col = 4 * lane + 256 * j;
                const f32x4 h = x[j] * r2 * *(const LAS f32x4*)(lv + 2048 + col) + *(const LAS f32x4*)(lv + 4096 + col); v2u w; w.x = pk2(h[0], h[1]); w.y = pk2(h[2], h[3]); *(v2u*)(ho + col) = w; }
        }
    }
    __syncthreads();
}

constexpr int PTAB_OFF = LDSCTL_OFF + 1024;
__device__ __forceinline__ const float* ldptr(LAS const unsigned long long* t, int i) {
    const unsigned long long v = t[i]; const unsigned lo = __builtin_amdgcn_readfirstlane((unsigned)v), hi = __builtin_amdgcn_readfirstlane((unsigned)(v >> 32));
    return (const float*)(GAS const float*)(((unsigned long long)hi << 32) | lo);
}
constexpr int I_IN = 32 * 192, I_GATE = 32 * 256, I_A = 8 * 64, I_B = 16 * 64, I_C = 8 * 64, I_D = 8 * 64, I_O = 32 * 64, I_UP = 32 * 352, I_DN = 88 * 64;
constexpr int I_LAYER = I_IN + I_GATE + I_A + I_B + I_C + I_D + I_O + I_UP + I_DN;
#define CONVERT_ITEM(LL, ITEM) do { const int l_ = (LL); int r = (ITEM); \
    const float* W; int N; bf16* WT; int ldw, koff = 0, rowoff = 0, up = 0; \
    if (r < I_IN) { W = IN(12) + (size_t)l_ * DM * DIN_; N = DIN_; WT = (bf16*)(ws + WS_WIG + l_ * SZ_WIG); ldw = DM; } \
    else if ((r -= I_IN) < I_GATE) { W = IN(27) + (size_t)l_ * DM * NGATE; N = NGATE; WT = (bf16*)(ws + WS_WIG + l_ * SZ_WIG); ldw = DM; rowoff = DIN_; } \
    else if ((r -= I_GATE) < I_A) { W = IN(17) + (size_t)l_ * 512 * DM; N = DM; WT = (bf16*)(ws + WS_WBR + l_ * SZ_WBR); ldw = KBR; koff = 0; } \
    else if ((r -= I_A) < I_B) { W = IN(23) + (size_t)l_ * 1024 * DM; N = DM; WT = (bf16*)(ws + WS_WBR + l_ * SZ_WBR); ldw = KBR; koff = 512; } \
    else if ((r -= I_B) < I_C) { W = IN(25) + (size_t)l_ * 512 * DM; N = DM; WT = (bf16*)(ws + WS_WBR + l_ * SZ_WBR); ldw = KBR; koff = 1536; } \
    else if ((r -= I_C) < I_D) { W = IN(26) + (size_t)l_ * 512 * DM; N = DM; WT = (bf16*)(ws + WS_WBR + l_ * SZ_WBR); ldw = KBR; koff = 2048; } \
    else if ((r -= I_D) < I_O) { W = IN(29) + (size_t)l_ * DM * DM; N = DM; WT = (bf16*)(ws + WS_WO + l_ * SZ_WO); ldw = DM; } \
    else if ((r -= I_O) < I_UP) { W = IN(30) + (size_t)l_ * DM * NUP; N = NUP; WT = (bf16*)(ws + WS_WUP + l_ * SZ_WUP); ldw = DM; up = 1; } \
    else { r -= I_UP; W = IN(31) + (size_t)l_ * DFF * DM; N = DM; WT = (bf16*)(ws + WS_WDN + l_ * SZ_WDN); ldw = DFF; } \
    transpose_item(W, N, WT, ldw, koff, rowoff, up, scr, r, lane); } while (0)
#define CONVERT_SLOT(NUNITS, B, E) do { if (l + 1 < nlayers) { const int rem_ = (NUNITS) % G, first_ = rem_; \
    if (bx >= first_) { LAS float* scr = (LAS float*)(lds + wave * 16384); const int nw_ = (G - first_) * 8; \
        for (int it = (B) + (bx - first_) * 8 + wave; it < (E); it += nw_) { CONVERT_ITEM(l + 1, it); } } } } while (0)
__global__ void __launch_bounds__(512, 2) mk_fwd(Params p) {
    extern __shared__ __attribute__((aligned(16))) unsigned char lds_raw[];
    LAS unsigned char* lds = (LAS unsigned char*)lds_raw;
    volatile LAS unsigned* MISC = (volatile LAS unsigned*)(lds + MISC_OFF);
    const int wave_s = __builtin_amdgcn_readfirstlane(threadIdx.x >> 6);
    for (int u = threadIdx.x; u < (LDS_BYTES - LDSCTL_OFF) / 4; u += 512) ((LAS unsigned*)(lds + LDSCTL_OFF))[u] = 0u;
    __syncthreads();
    if (threadIdx.x == 0) { LAS unsigned long long* t = (LAS unsigned long long*)(lds + PTAB_OFF);
#pragma unroll
        for (int i = 0; i < 32; ++i) t[i] = (unsigned long long)p.in[i];
        t[32] = (unsigned long long)p.out; t[33] = (unsigned long long)p.ws; }
    __syncthreads();
    (void)xcd_barrier_post((unsigned*)(p.ws + WS_CTL) + CW_BAR, MISC + 8);
#ifndef MK_STOP
#define MK_STOP 0
#endif
#ifndef MI_LEFT
#define MI_LEFT 2
#endif
#ifndef MI_UP
#define MI_UP 4
#endif
#ifndef MI_N
#define MI_N 3
#endif
#ifndef MK_TPROBE
#define MK_TPROBE (-1)
#endif
#ifndef MK_TAMP
#define MK_TAMP 4
#endif
#if MK_TPROBE >= 0
#define TSTART(id) do { if ((id) == MK_TPROBE && blockIdx.x == 0 && wave_s == 0) MISC[18] = (unsigned)__builtin_amdgcn_s_memrealtime(); } while (0)
#define TSTOP(id) do { if ((id) == MK_TPROBE && blockIdx.x == 0 && wave_s == 0) MISC[16] = MISC[16] + ((unsigned)__builtin_amdgcn_s_memrealtime() - MISC[18]); } while (0)
#else
#define TSTART(id) do {} while (0)
#define TSTOP(id) do {} while (0)
#endif
#define RUN(k) (MK_STOP == 0 || (MK_STOP >= (k) && MK_STOP < 11) || (MK_STOP == 11 && (k) == 1))
#define GRID_BAR() do { unsigned pto2_ = PTAB_OFF; asm volatile("" : "+s"(pto2_)); XcdBarrier b_; \
    b_.bar = (unsigned*)((unsigned char*)ldptr((LAS const unsigned long long*)(lds + pto2_), 33) + WS_CTL) + CW_BAR; b_.x = xb_xcc_id(); b_.st = MISC + 8; xcd_barrier(b_); } while (0)
#define PH_BEGIN() int tid; unsigned pto_ = PTAB_OFF; int G = gridDim.x, bx = blockIdx.x; \
    asm volatile("v_mbcnt_lo_u32_b32 %0, -1, 0\n\tv_mbcnt_hi_u32_b32 %0, -1, %0" : "=v"(tid), "+s"(pto_), "+s"(G), "+s"(bx)); tid += wave_s * 64; \
    const int vcu = (G % 8 == 0) ? (bx % 8) * (G / 8) + bx / 8 : bx, NGW = G * 8, NGT = G * 512; (void)NGW; (void)NGT; \
    LAS const unsigned long long* const pt_ = (LAS const unsigned long long*)(lds + pto_); unsigned char* const ws = (unsigned char*)ldptr(pt_, 33); float* const outp = (float*)ldptr(pt_, 32); (void)outp; \
    const int lane = tid & 63, wave = __builtin_amdgcn_readfirstlane(tid >> 6), gw = vcu * 8 + wave, gt = vcu * 512 + tid; (void)lane; (void)gw; (void)gt
#define MOD ((float*)(ws + WS_MOD))
#define PARTMOD ((float*)(ws + WS_PARTMOD))
#define LAM ((float*)(ws + WS_LAM))
#define ROPE ((float*)(ws + WS_ROPE))
#define TWC ((bf16*)(ws + WS_TWC))
#define TW256 ((bf16*)(ws + WS_TW256))
#define TW1024 ((bf16*)(ws + WS_TW1024))
#define Hb ((bf16*)(ws + WS_H))
#define PROJ ((bf16*)(ws + WS_PROJ))
#define GATES ((unsigned char*)(ws + WS_GATES))
#define KCTX ((bf16*)(ws + WS_KCTX))
#define VCTX ((bf16*)(ws + WS_VCTX))
#define AO ((bf16*)(ws + WS_AO))
#define ML ((float*)(ws + WS_ML))
#define BR ((bf16*)(ws + WS_BR))
#define PQC ((bf16*)(ws + WS_PQC))
#define PQL ((bf16*)(ws + WS_PQL))
#define PART ((unsigned*)(ws + WS_PART))
#define MERGED ((bf16*)(ws + WS_MERGED))
#define MIX ((float*)(ws + WS_MIX))
#define SSQ ((float*)(ws + WS_SSQ))
#define FACT ((bf16*)(ws + WS_FACT))
#define X (outp + OUT_Y)
#define IN(i) ldptr(pt_, i)
#define MODl (MOD + (size_t)l * 3 * N_ADA)
#define KLATl ((bf16*)(ws + WS_KLAT + l * SZ_KLAT))
#define VLATl ((bf16*)(ws + WS_VLAT + l * SZ_KLAT))

    TSTART(0);
    {
        PH_BEGIN();
        LAS float* scr = (LAS float*)(lds + wave * 16384);
        for (int it = gw; it < NL * I_LAYER; it += NGW) { CONVERT_ITEM(it / I_LAYER, it % I_LAYER); }
        for (int it = gw; it < NL * 32 * 48; it += NGW) {
            const int l = it / 1536, r = it % 1536, ks = r / 48, nc = r % 48, k0 = ks * 64, n = nc * 256 + 4 * lane;
            float c0 = IN(5)[k0 + lane], c1 = IN(4)[k0 + lane], c2 = IN(4)[DM + k0 + lane];
            c0 = c0 / (1.0f + __expf(-c0)); c1 = c1 / (1.0f + __expf(-c1)); c2 = c2 / (1.0f + __expf(-c2));
            const float* wp = IN(6) + ((size_t)l * DM + k0) * N_ADA + n;
            f32x4 a0 = {0.f, 0.f, 0.f, 0.f}, a1 = a0, a2 = a0;
#pragma unroll 8
            for (int k = 0; k < 64; ++k) { const f32x4 w = *(const f32x4*)(wp + (size_t)k * N_ADA);
                const float s0 = __shfl(c0, k), s1 = __shfl(c1, k), s2 = __shfl(c2, k); a0 += w * s0; a1 += w * s1; a2 += w * s2; }
            float* po = PARTMOD + ((size_t)(l * 32 + ks) * 3) * N_ADA + n;
            *(f32x4*)(po) = a0; *(f32x4*)(po + N_ADA) = a1; *(f32x4*)(po + 2 * N_ADA) = a2;
        }
        for (int i = gt; i < 2 * 524288; i += NGT) {
            const int t = i >= 524288 ? 1 : 0, j = i - t * 524288; const size_t e = (size_t)j * 8;
            const int b = (int)(e >> 21), l = (int)(e >> 19) & 3, tt = (int)(e >> 10) & 511, c = (int)e & 1023;
            const float* src = (t ? IN(3) : IN(2)) + e; const f32x4 v0 = *(const f32x4*)src, v1 = *(const f32x4*)(src + 4);
            v4u o; o.x = pk2(v0[0], v0[1]); o.y = pk2(v0[2], v0[3]); o.z = pk2(v1[0], v1[1]); o.w = pk2(v1[2], v1[3]);
            bf16* dst = (bf16*)(ws + (t ? WS_VLAT : WS_KLAT) + l * SZ_KLAT) + ((size_t)(b * 1536 + tt)) * 1024 + c;
            *(v4u*)dst = o;
        }
        for (int i = gt; i < 512 * 256; i += NGT) { const int mr = i >> 8, kk = i & 255, gg = mr >> 8, pq = (mr >> 7) & 1, j = mr & 127, gg2 = kk >> 7, c = kk & 127;
            const float ang = (float)((j * c) & 127) * (2.0f / 128.0f); float v = pq ? sinpif(ang) : cospif(ang); v *= 0.08838834764831845f;
            TWC[i] = (bf16)f2bf(gg == gg2 ? v : 0.f); }
        for (int i = gt; i < 256 * 512; i += NGT) { const int k = i >> 9, kk = i & 511, pq = kk >> 8, t = kk & 255; const float ang = (float)((k * t) & 255) * (2.0f / 256.0f);
            const float v = (pq ? -sinpif(ang) : cospif(ang)) * 0.0625f; TW256[i] = (bf16)f2bf(v); }
        for (int i = gt; i < 1024 * 2048; i += NGT) { const int k = i >> 11, kk = i & 2047, pq = kk >> 10, t = kk & 1023; const float ang = (float)((k * t) & 1023) * (2.0f / 1024.0f);
            const float v = (pq ? -sinpif(ang) : cospif(ang)) * 0.03125f; TW1024[i] = (bf16)f2bf(v); }
        for (int i = gt; i < 64 * 32; i += NGT) { const int pos = i >> 5, fi = i & 31; const float inv = powf(10000.0f, -(float)(2 * fi) / 64.0f); const float a = (float)pos * inv;
            ROPE[2 * i] = cosf(a); ROPE[2 * i + 1] = sinf(a); }
        if (gt < NL) { const int l = gt; float s1 = 0.f, s2 = 0.f;
            for (int k = 0; k < 128; ++k) { s1 += IN(18)[l * 128 + k] * IN(19)[l * 128 + k]; s2 += IN(20)[l * 128 + k] * IN(21)[l * 128 + k]; }
            const float li = 0.8f - 0.6f * expf(-0.3f * (float)l); LAM[2 * l] = expf(s1) - expf(s2) + li; LAM[2 * l + 1] = 1.0f - li; }
    }
    GRID_BAR();
    { PH_BEGIN();
    for (int i = gt; i < NL * 3 * N_ADA; i += NGT) { const int l = i / (3 * N_ADA), r = i % (3 * N_ADA), v = r / N_ADA, n = r % N_ADA; float s = IN(7)[l * N_ADA + n];
        for (int ks = 0; ks < 32; ++ks) s += PARTMOD[((size_t)(l * 32 + ks) * 3 + v) * N_ADA + n];
        MOD[i] = s; } }
    GRID_BAR();
    { PH_BEGIN(); row_phase<false>(vcu, G, tid, (LAS float*)lds, IN(0), IN(1), X, nullptr, nullptr, nullptr, nullptr, true, IN(8), MOD + 2048, MOD, Hb); }
    GRID_BAR();
    TSTOP(0);

    int nlayers = MK_LAYERS; asm volatile("" : "+s"(nlayers));
    for (int l = 0; l < nlayers; ++l) {
        TSTART(1);
        if (RUN(1)) {
            PH_BEGIN();
            const int nfull1 = (24 * 56 / G) * G;
            pg8::SchedMain S{24, 56, G, bx, nfull1, (const char*)Hb, (const char*)(ws + WS_WIG + l * SZ_WIG), (size_t)DM * 2, (size_t)DM * 2, pg8::G1_PN};
            pg8::EpiG1<4> E{PROJ, GATES, KCTX, VCTX, KLATl, VLATl, outp + OUT_NK + (size_t)l * 256 * 1024, outp + OUT_NV + (size_t)l * 256 * 1024, IN(28) + (size_t)l * NGATE};
            pg8::gemm_stream<pg8::EpiG1<4>, pg8::SchedMain>(lds, tid, DM, DM, S, E);
            pg8::SchedLeft<MI_LEFT> S2{24, 56, G, bx, nfull1, (const char*)Hb, (const char*)(ws + WS_WIG + l * SZ_WIG), (size_t)DM * 2, (size_t)DM * 2, pg8::G1_PN};
            pg8::EpiG1<MI_LEFT> E2{PROJ, GATES, KCTX, VCTX, KLATl, VLATl, outp + OUT_NK + (size_t)l * 256 * 1024, outp + OUT_NV + (size_t)l * 256 * 1024, IN(28) + (size_t)l * NGATE};
            pg8::gemm_stream<pg8::EpiG1<MI_LEFT>, pg8::SchedLeft<MI_LEFT>, MI_LEFT>(lds, tid, DM, DM, S2, E2);
        }
        GRID_BAR();
        TSTOP(1);
        TSTART(2);
        if (RUN(2)) {
            { PH_BEGIN();
            for (int i = gt; i < 2048 * 128; i += NGT) {
                const int tok = i >> 7, r = i & 127, tensor = r >> 6, h = (r >> 4) & 3, m = (r >> 3) & 1, half = (r >> 2) & 1, j8 = r & 3;
                const int b = tok >> 10, t = tok & 1023, pos = half ? (t & 63) : (t >> 6);
                bf16* q = tensor == 0 ? PROJ + (size_t)(MCTX + tok) * DIN_ + 1024 : KLATl + (size_t)(b * 1536 + 512 + t) * 1024;
                q += h * 256 + m * 128 + half * 64 + j8 * 8;
                const v4u x1 = *(const v4u*)q, x2 = *(const v4u*)(q + 32);
                const float* cs = ROPE + (size_t)(pos * 32 + j8 * 8) * 2;
                const f32x4 t0 = *(const f32x4*)cs, t1 = *(const f32x4*)(cs + 4), t2 = *(const f32x4*)(cs + 8), t3 = *(const f32x4*)(cs + 12);
                const float co[8] = {t0[0], t0[2], t1[0], t1[2], t2[0], t2[2], t3[0], t3[2]}, si[8] = {t0[1], t0[3], t1[1], t1[3], t2[1], t2[3], t3[1], t3[3]};
                const unsigned xa[4] = {x1.x, x1.y, x1.z, x1.w}, xb[4] = {x2.x, x2.y, x2.z, x2.w}; unsigned oa[4], ob[4];
#pragma unroll
                for (int e = 0; e < 4; ++e) { const float a0 = bf_lo(xa[e]), a1 = bf_hi(xa[e]), b0 = bf_lo(xb[e]), b1 = bf_hi(xb[e]);
                    oa[e] = pk2(a0 * co[2 * e] - b0 * si[2 * e], a1 * co[2 * e + 1] - b1 * si[2 * e + 1]);
                    ob[e] = pk2(b0 * co[2 * e] + a0 * si[2 * e], b1 * co[2 * e + 1] + a1 * si[2 * e + 1]); }
                *(v4u*)q = (v4u){oa[0], oa[1], oa[2], oa[3]}; *(v4u*)(q + 32) = (v4u){ob[0], ob[1], ob[2], ob[3]};
            }
            }
            {
                PH_BEGIN();
                const float* wc3 = IN(24) + (size_t)l * 3 * 512;
                for (int i = gt; i < MTOK * 64; i += NGT) {
                    const int row = i >> 6, c8 = (i & 63) * 8; int s0, T; if (row < MCTX) { s0 = row & ~255; T = 256; } else { s0 = MCTX + ((row - MCTX) & ~1023); T = 1024; }
                    float acc8[8] = {0.f, 0.f, 0.f, 0.f, 0.f, 0.f, 0.f, 0.f};
#pragma unroll
                    for (int dk = 0; dk < 3; ++dk) { const int g = row + dk - 1;
                        if (g >= s0 && g < s0 + T) { const bf16* pr = PROJ + (size_t)g * DIN_ + c8; const v4u sc = *(const v4u*)(pr + 4608), sx = *(const v4u*)(pr + 5120);
                            const f32x4 w0 = *(const f32x4*)(wc3 + dk * 512 + c8), w1 = *(const f32x4*)(wc3 + dk * 512 + c8 + 4);
                            const unsigned sa[4] = {sc.x, sc.y, sc.z, sc.w}, sb[4] = {sx.x, sx.y, sx.z, sx.w}; const float wv[8] = {w0[0], w0[1], w0[2], w0[3], w1[0], w1[1], w1[2], w1[3]};
#pragma unroll
                            for (int e = 0; e < 4; ++e) { acc8[2 * e] += wv[2 * e] * (bf_lo(sa[e]) * bf_lo(sb[e])); acc8[2 * e + 1] += wv[2 * e + 1] * (bf_hi(sa[e]) * bf_hi(sb[e])); } } }
                    const v4u sbv = *(const v4u*)(PROJ + (size_t)row * DIN_ + 4096 + c8); const unsigned sbb[4] = {sbv.x, sbv.y, sbv.z, sbv.w}; unsigned o[4];
#pragma unroll
                    for (int e = 0; e < 4; ++e) o[e] = pk2(bf_lo(sbb[e]) * acc8[2 * e], bf_hi(sbb[e]) * acc8[2 * e + 1]);
                    *(v4u*)(BR + (size_t)row * KBR + 1536 + c8) = (v4u){o[0], o[1], o[2], o[3]};
                }
            }
            {
                PH_BEGIN();
                const int c = tid; float w[31];
#pragma unroll
                for (int k = 0; k < 31; ++k) w[k] = IN(13)[((size_t)l * 31 + k) * 512 + c];
                const float cb = IN(14)[l * 512 + c];
                LAS float* so = (LAS float*)lds;
                for (int u = vcu; u < MTOK / 16; u += G) {
                    const int row0 = u * 16; int s0, T; if (row0 < MCTX) { s0 = row0 & ~255; T = 256; } else { s0 = MCTX + ((row0 - MCTX) & ~1023); T = 1024; }
                    float in[46];
#pragma unroll
                    for (int r = 0; r < 46; ++r) { const int g = row0 - 15 + r; float v = 0.f;
                        if (g >= s0 && g < s0 + T) { const bf16* pr = PROJ + (size_t)g * DIN_ + c; v = bf2f(pr[0]) * sigmoid_f(bf2f(pr[512])); }
                        in[r] = v; }
#pragma unroll
                    for (int t = 0; t < 16; ++t) { float o = cb;
#pragma unroll
                        for (int k = 0; k < 31; ++k) o += w[k] * in[t + k];
                        so[t * 512 + c] = o; }
                    __syncthreads();
#pragma unroll
                    for (int q = 0; q < 2; ++q) { const int t = 2 * wave + q; float v[8]; float s = 0.f;
#pragma unroll
                        for (int j = 0; j < 8; ++j) { v[j] = so[t * 512 + lane + 64 * j]; s += v[j]; }
                        const float mean = wave_sum(s) * (1.0f / 512.0f); float s2 = 0.f;
#pragma unroll
                        for (int j = 0; j < 8; ++j) { v[j] -= mean; s2 += v[j] * v[j]; }
                        const float rstd = __builtin_amdgcn_rsqf(wave_sum(s2) * (1.0f / 512.0f) + EPS_);
#pragma unroll
                        for (int j = 0; j < 8; ++j) { const int cc = lane + 64 * j; float y = v[j] * rstd * IN(15)[l * 512 + cc] + IN(16)[l * 512 + cc]; y = y * sigmoid_f(y);
                            BR[(size_t)(row0 + t) * KBR + cc] = (bf16)f2bf(y); } }
                    __syncthreads();
                }
            }
            {
                PH_BEGIN();
                int nt4 = 4; asm volatile("" : "+s"(nt4));
                const int nconv2 = (MTOK / 16) - G;
                const bool place = nconv2 >= 0 && G - nconv2 >= 96;
                pg8::SchedF1 S{place ? 96 : G, place ? (vcu >= nconv2 ? vcu - nconv2 : 96) : bx, nt4, (const char*)TWC, (const char*)PROJ};
                pg8::EpiF1 E{PQC, PQL};
                pg8::gemm_stream<pg8::EpiF1, pg8::SchedF1>(lds, tid, 256, DIN_, S, E);
            }
        }
        GRID_BAR();
        TSTOP(2);
        TSTART(3);
        if (RUN(3)) {
            { PH_BEGIN();
            for (int ui = vcu; ui < 512; ui += G) {
                const bf16 *Q, *K, *V; bf16* Ob; float* MLb; int seq;
                if (ui < 256) { const int u = ui, split = u & 1, qb = (u >> 1) & 3, vh = (u >> 3) & 1, m = (u >> 4) & 1, h = (u >> 5) & 3, b = u >> 7;
                    const int tok0 = MCTX + b * 1024 + qb * 256, slot = (h * 2 + m) * 2 + vh;
                    Q = PROJ + (size_t)tok0 * DIN_ + 1024 + h * 256 + m * 128;
                    K = KLATl + (size_t)(b * 1536 + split * 768) * 1024 + h * 256 + m * 128; V = VLATl + (size_t)(b * 1536 + split * 768) * 1024 + h * 256 + vh * 128;
                    Ob = AO + ((size_t)split * MTOK + tok0) * 2048 + slot * 128; MLb = ML + (((size_t)split * 16 + slot) * MTOK + tok0) * 2; seq = 768; }
                else { const int u = ui - 256, vh = u & 1, m = (u >> 1) & 1, h = (u >> 2) & 3, s = u >> 4; const int tok0 = s * 256, slot = (h * 2 + m) * 2 + vh;
                    Q = PROJ + (size_t)tok0 * DIN_ + 1024 + h * 256 + m * 128;
                    K = KCTX + (size_t)tok0 * 1024 + h * 256 + m * 128; V = VCTX + (size_t)tok0 * 1024 + h * 256 + vh * 128;
                    Ob = AO + (size_t)tok0 * 2048 + slot * 128; MLb = ML + ((size_t)slot * MTOK + tok0) * 2; seq = 256; }
                att::attn_unit(Q, K, V, Ob, MLb, seq, (LAS char*)lds, tid);
            } }
            {
                PH_BEGIN();
                pg8::SchedF2L S{G, bx, (const char*)TW1024, (const char*)PQL};
                pg8::EpiF2P E{(float*)(ws + WS_FP)};
                pg8::gemm_stream<pg8::EpiF2P, pg8::SchedF2L>(lds, tid, 2048, 2048, S, E);
            }
            {
                PH_BEGIN();
                pg8::SchedF2C S{G, bx, (const char*)TW256, (const char*)PQC};
                pg8::EpiBf16 E{BR, KBR, 2048};
                pg8::gemm_stream<pg8::EpiBf16, pg8::SchedF2C>(lds, tid, 512, 512, S, E);
            }
        }
        GRID_BAR();
        TSTOP(3);
        TSTART(4);
        if (RUN(4)) {
            PH_BEGIN();
            {
                const float* fp = (const float*)(ws + WS_FP);
                for (int t = gw; t < 2048; t += NGW) { const float* r0 = fp + (size_t)t * 512 + 8 * lane; f32x4 a0 = *(const f32x4*)r0, a1 = *(const f32x4*)(r0 + 4);
#pragma unroll
                    for (int ks = 1; ks < 4; ++ks) { a0 += *(const f32x4*)(r0 + (size_t)ks * 2048 * 512); a1 += *(const f32x4*)(r0 + (size_t)ks * 2048 * 512 + 4); }
                    v4u w; w.x = pk2(a0[0], a0[1]); w.y = pk2(a0[2], a0[3]); w.z = pk2(a1[0], a1[1]); w.w = pk2(a1[2], a1[3]);
                    *(v4u*)(BR + (size_t)(MCTX + t) * KBR + 2048 + 8 * lane) = w; }
            }
            const float lam = LAM[2 * l], oml = LAM[2 * l + 1]; constexpr float C = att::SCALE * 1.4426950408889634f;
            for (int tok = gw; tok < MTOK; tok += NGW) {
                const int vh = lane >> 5, d4 = (lane & 31) * 4; const bool two = tok >= MCTX;
                v2u o0w[4][2], o1w[4][2]; float m0[4][2], l0[4][2], m1[4][2], l1[4][2];
#pragma unroll
                for (int h = 0; h < 4; ++h)
#pragma unroll
                    for (int m = 0; m < 2; ++m) { const int slot = (h * 2 + m) * 2 + vh;
                        o0w[h][m] = *(const v2u*)(AO + (size_t)tok * 2048 + slot * 128 + d4); m0[h][m] = ML[((size_t)slot * MTOK + tok) * 2]; l0[h][m] = ML[((size_t)slot * MTOK + tok) * 2 + 1];
                        if (two) { o1w[h][m] = *(const v2u*)(AO + ((size_t)MTOK + tok) * 2048 + slot * 128 + d4); m1[h][m] = ML[((size_t)(16 + slot) * MTOK + tok) * 2]; l1[h][m] = ML[((size_t)(16 + slot) * MTOK + tok) * 2 + 1]; }
                        else { o1w[h][m] = (v2u){0u, 0u}; m1[h][m] = 0.f; l1[h][m] = 0.f; } }
                f32x4 gq[4];
#pragma unroll
                for (int h = 0; h < 4; ++h) gq[h] = *(const f32x4*)(IN(22) + l * 256 + vh * 128 + d4);
#pragma unroll
                for (int h = 0; h < 4; ++h) {
                    f32x4 val[2];
#pragma unroll
                    for (int m = 0; m < 2; ++m) { const v2u a0 = o0w[h][m]; const f32x4 o0 = {bf_lo(a0.x), bf_hi(a0.x), bf_lo(a0.y), bf_hi(a0.y)};
                        if (two) { const v2u a1 = o1w[h][m]; const f32x4 o1 = {bf_lo(a1.x), bf_hi(a1.x), bf_lo(a1.y), bf_hi(a1.y)};
                            const float mm = fmaxf(m0[h][m], m1[h][m]), e0 = __builtin_amdgcn_exp2f((m0[h][m] - mm) * C), e1 = __builtin_amdgcn_exp2f((m1[h][m] - mm) * C);
                            val[m] = (o0 * e0 + o1 * e1) * (1.0f / (l0[h][m] * e0 + l1[h][m] * e1)); }
                        else val[m] = o0 * (1.0f / l0[h][m]); }
                    const f32x4 o = val[0] - val[1] * lam;
                    const float ss = wave_sum((o[0] * o[0] + o[1] * o[1]) + (o[2] * o[2] + o[3] * o[3]));
                    const float rs = __builtin_amdgcn_rsqf(ss * (1.0f / 256.0f) + EPS_) * oml;
                    const f32x4 r = o * rs * gq[h];
                    v2u w; w.x = pk2(r[0], r[1]); w.y = pk2(r[2], r[3]); *(v2u*)(BR + (size_t)tok * KBR + 512 + h * 256 + vh * 128 + d4) = w;
                }
            }
        }
        GRID_BAR();
        TSTOP(4);
        TSTART(5);
        if (RUN(5)) {
            PH_BEGIN();
            pg8::SchedG2<MI_N> S{G, bx, (const char*)BR, (const char*)(ws + WS_WBR + l * SZ_WBR)};
            pg8::EpiG2<MI_N> E{GATES, PART, MERGED};
            pg8::gemm_stream<pg8::EpiG2<MI_N>, pg8::SchedG2<MI_N>, MI_N>(lds, tid, KBR, KBR, S, E);
        }
        GRID_BAR();
        TSTOP(5);
        TSTART(6);
        if (RUN(6)) {
            PH_BEGIN();
            pg8::TileSched S{MTOK / (64 * MI_N), 8, G, bx, 32, (const char*)MERGED, (const char*)(ws + WS_WO + l * SZ_WO), (size_t)(64 * MI_N) * DM * 2, (size_t)256 * DM * 2};
            pg8::EpiSsq<MI_N> E{MIX, SSQ};
            pg8::gemm_stream<pg8::EpiSsq<MI_N>, pg8::TileSched, MI_N>(lds, tid, DM, DM, S, E);
        }
        GRID_BAR();
        TSTOP(6);
        TSTART(7);
        if (RUN(7)) { PH_BEGIN(); row_phase<true>(vcu, G, tid, (LAS float*)lds, X, X + (size_t)MCTX * DM, X, MIX, SSQ, MODl + 4096, IN(9) + l * DM, true, IN(10) + l * DM, MODl + 8192, MODl + 6144, Hb); }
        GRID_BAR();
        TSTOP(7);
        TSTART(8);
        if (RUN(8)) {
            PH_BEGIN();
            const int nfull4 = (24 * 44 / G) * G;
            pg8::SchedMain S{24, 44, G, bx, nfull4, (const char*)Hb, (const char*)(ws + WS_WUP + l * SZ_WUP), (size_t)DM * 2, (size_t)DM * 2, nullptr};
            pg8::EpiSwiGLU<4> E{FACT};
            pg8::gemm_stream<pg8::EpiSwiGLU<4>, pg8::SchedMain>(lds, tid, DM, DM, S, E);
            pg8::SchedLeft<MI_LEFT> S2{24, 44, G, bx, nfull4, (const char*)Hb, (const char*)(ws + WS_WUP + l * SZ_WUP), (size_t)DM * 2, (size_t)DM * 2, nullptr};
            pg8::EpiSwiGLU<MI_LEFT> E2{FACT};
            pg8::gemm_stream<pg8::EpiSwiGLU<MI_LEFT>, pg8::SchedLeft<MI_LEFT>, MI_LEFT>(lds, tid, DM, DM, S2, E2);
        }
        GRID_BAR();
        TSTOP(8);
        TSTART(9);
        if (RUN(9)) {
            PH_BEGIN();
            pg8::TileSched S{MTOK / (64 * MI_N), 8, G, bx, 88, (const char*)FACT, (const char*)(ws + WS_WDN + l * SZ_WDN), (size_t)(64 * MI_N) * DFF * 2, (size_t)256 * DFF * 2};
            pg8::EpiSsq<MI_N> E{MIX, SSQ};
            pg8::gemm_stream<pg8::EpiSsq<MI_N>, pg8::TileSched, MI_N>(lds, tid, DFF, DFF, S, E);
        }
        GRID_BAR();
        TSTOP(9);
        TSTART(10);
        if (RUN(10)) {
            PH_BEGIN();
            const bool more = (l + 1 < NL); const int ln = more ? l + 1 : l;
            row_phase<true>(vcu, G, tid, (LAS float*)lds, X, X + (size_t)MCTX * DM, X, MIX, SSQ, MODl + 10240, IN(11) + l * DM, more, IN(8) + ln * DM, MOD + (size_t)ln * 3 * N_ADA + 2048, MOD + (size_t)ln * 3 * N_ADA, Hb);
        }
        if (l + 1 < nlayers) GRID_BAR();
        TSTOP(10);
    }
#if MK_TPROBE >= 0
    if (blockIdx.x == 0 && wave_s == 0) { asm volatile("s_waitcnt vmcnt(0)" ::: "memory"); const unsigned long long t0 = __builtin_amdgcn_s_memrealtime(), d = (unsigned long long)MISC[16] * MK_TAMP;
        while (__builtin_amdgcn_s_memrealtime() - t0 < d) __builtin_amdgcn_s_sleep(8); }
#endif
#if MK_STOP
    { GRID_BAR(); PH_BEGIN();
      for (size_t i = gt; i < (size_t)MTOK * DM; i += NGT) { const size_t row = i >> 11; const int col = (int)(i & 2047); float v = 0.f;
        if (MK_STOP == 2) v = col < 512 ? bf2f(BR[row * KBR + col]) : (col < 1024 ? bf2f(BR[row * KBR + 1536 + col - 512]) : bf2f(PROJ[row * DIN_ + col]));
        else if (MK_STOP == 3) v = bf2f(AO[row * 2048 + col]);
        else if (MK_STOP == 4) v = col < 1024 ? bf2f(BR[row * KBR + 512 + col]) : (col < 1536 ? bf2f(BR[row * KBR + 2048 + col - 1024]) : 0.f);
        else if (MK_STOP == 5) v = bf2f(MERGED[i]);
        else if (MK_STOP == 6 || MK_STOP == 9) v = MIX[i];
        else if (MK_STOP == 8) v = bf2f(FACT[row * DFF + col]);
        else if (MK_STOP == 11) v = (float)GATES[row * NGATE + col];
        else continue;
        X[i] = v; } }
#endif
#if MK_LAYERS < 4
    PH_BEGIN();
    for (size_t i = gt; i < (size_t)16 * 4 * 256 * 1024; i += NGT) { const int l = (int)((i >> 18) & 3); if (l >= MK_LAYERS) { outp[OUT_NK + i] = 0.f; outp[OUT_NV + i] = 0.f; } }
#endif
#undef GRID_BAR
}

extern "C" void kernel_launch(void* const* d_in, const int* in_sizes, int n_in, void* d_out, int out_size, void* d_ws, size_t ws_size, hipStream_t stream) {
    static int grid = 0;
    if (grid == 0) {
        if (n_in != 32 || (size_t)out_size != OUT_TOTAL || ws_size < WS_END) { fprintf(stderr, "kernel_launch: built for 32 inputs, %zu outputs, >= %zu bytes of workspace; got n_in %d, out %d, ws %zu; nothing launched\n", OUT_TOTAL, (size_t)WS_END, n_in, out_size, ws_size); grid = -1; return; }
        int dev = 0, cus = 0, per_cu = 0;
        if (hipGetDevice(&dev) != hipSuccess || hipDeviceGetAttribute(&cus, hipDeviceAttributeMultiprocessorCount, dev) != hipSuccess) { fprintf(stderr, "kernel_launch: device query failed\n"); grid = -1; return; }
        if (hipFuncSetAttribute((const void*)mk_fwd, hipFuncAttributeMaxDynamicSharedMemorySize, LDS_BYTES) != hipSuccess) { fprintf(stderr, "kernel_launch: hipFuncSetAttribute failed\n"); grid = -1; return; }
        if (hipOccupancyMaxActiveBlocksPerMultiprocessor(&per_cu, (const void*)mk_fwd, 512, LDS_BYTES) != hipSuccess || per_cu < 1) { fprintf(stderr, "kernel_launch: occupancy query reports %d workgroups per CU\n", per_cu); }
        (void)hipGetLastError();
        grid = cus;
    }
    if (grid < 0) return;
#ifdef MK_ZERO_WS
    (void)hipMemsetAsync((char*)d_ws, 0, WS_END, stream);
#endif
    if (hipMemsetAsync((char*)d_ws + WS_CTL, 0, CTL_ZERO_BYTES, stream) != hipSuccess) { fprintf(stderr, "kernel_launch: hipMemsetAsync failed\n"); return; }
    Params p{};
    for (int i = 0; i < 32; ++i) p.in[i] = (const float*)d_in[i];
    p.out = (float*)d_out; p.ws = (unsigned char*)d_ws;
    hipLaunchKernelGGL(mk_fwd, dim3(grid), dim3(512), LDS_BYTES, stream, p);
    const hipError_t le = hipPeekAtLastError();
    if (le != hipSuccess) fprintf(stderr, "kernel_launch: launch failed: %s\n", hipGetErrorName(le));
}
```

```cpp
#include <hip/hip_runtime.h>
#include <cstdio>
#include <cstdint>

#ifndef MK_LAYERS
#define MK_LAYERS 4
#endif

#define GAS __attribute__((address_space(1)))
#define LAS __attribute__((address_space(3)))
typedef unsigned short bf16;
typedef unsigned v4u __attribute__((ext_vector_type(4)));
typedef unsigned v2u __attribute__((ext_vector_type(2)));
typedef float f32x4 __attribute__((ext_vector_type(4)));
typedef float f32x8 __attribute__((ext_vector_type(8)));
typedef float f32x16 __attribute__((ext_vector_type(16)));
typedef short bf16x8 __attribute__((ext_vector_type(8)));
typedef short s16x4 __attribute__((ext_vector_type(4)));
typedef GAS unsigned gu32;
#define RLX_AGENT __ATOMIC_RELAXED, __HIP_MEMORY_SCOPE_AGENT
#define LDS_WAIT() asm volatile("s_waitcnt lgkmcnt(0)" ::: "memory")
#define VM_WAIT() asm volatile("s_waitcnt vmcnt(0)" ::: "memory")
__device__ __forceinline__ unsigned f2bf(float f) { unsigned u = __builtin_bit_cast(unsigned, f); return (u + 0x7fffu + ((u >> 16) & 1u)) >> 16; }
__device__ __forceinline__ unsigned pk2(float lo, float hi) { return f2bf(lo) | (f2bf(hi) << 16); }
__device__ __forceinline__ float bf_lo(unsigned w) { return __builtin_bit_cast(float, w << 16); }
__device__ __forceinline__ float bf_hi(unsigned w) { return __builtin_bit_cast(float, w & 0xffff0000u); }
__device__ __forceinline__ float bf2f(bf16 b) { return __builtin_bit_cast(float, ((unsigned)b) << 16); }
__device__ __forceinline__ float sigmoid_f(float x) { return __builtin_amdgcn_rcpf(1.0f + __builtin_amdgcn_exp2f(-1.4426950408889634f * x)); }
typedef float f32x2c_t __attribute__((ext_vector_type(2)));
typedef __bf16 bf16x2c_t __attribute__((ext_vector_type(2)));
__device__ __forceinline__ unsigned cvt_pk_bf16_c(float lo, float hi) { f32x2c_t v = {lo, hi}; bf16x2c_t b = __builtin_convertvector(v, bf16x2c_t); return __builtin_bit_cast(unsigned, b); }
__device__ __forceinline__ float wave_sum(float v) {
#pragma unroll
    for (int o = 1; o < 64; o <<= 1) v += __shfl_xor(v, o);
    return v;
}

namespace pg8 {
#define PG8_LAS __attribute__((address_space(3)))
typedef unsigned short bf16_t;
typedef unsigned u32x4 __attribute__((ext_vector_type(4)));
typedef unsigned u32x2 __attribute__((ext_vector_type(2)));
constexpr int BM = 256, BK = 64, HALF = 128, HTB = HALF * BK * 2  , STAGE_BYTES = 8 * HTB, NXCD = 8, WGM = 8;

__host__ __device__ __forceinline__ int lds_byte(int r, int c) { const int st = (r >> 4) * 2 + (c >> 5), rr = r & 15, cc = c & 31, ob = rr * 64 + cc * 2; return st * 1024 + (ob ^ (((ob >> 9) & 1) << 5)); }
__host__ __device__ __forceinline__ void stage_rc(int b, int& R, int& C) { const int st = b / 1024, sb = b % 1024, swz = sb ^ (((sb >> 9) & 1) << 5); R = (st >> 1) * 16 + swz / 64; C = (st & 1) * 32 + (swz % 64) / 2; }
__host__ __device__ __forceinline__ int perm32(int rho) { const int n = rho >> 4, i = rho & 15; return 8 * (i >> 2) + 4 * n + (i & 3); }

struct Unit { int pm, pn, aux, nt; const char* A; const char* B; };

__device__ __forceinline__ bool tile_order(long L, int nM, int nN, int& pm, int& pn) {
    const int nwg = nM * nN; if (L >= nwg) return false;
    int wgid = (int)L; { const int q = nwg / NXCD, r = nwg % NXCD, xcd = wgid % NXCD, off = wgid / NXCD; wgid = (xcd < r ? xcd * (q + 1) : r * (q + 1) + (xcd - r) * q) + off; }
    const int nig = WGM * nN, gid = wgid / nig, fm = gid * WGM, gsz = (nM - fm) < WGM ? (nM - fm) : WGM;
    pm = fm + ((wgid % nig) % gsz); pn = (wgid % nig) / gsz; return true;
}
struct TileSched {
    int nM, nN, G, c, nt; const char* A; const char* B; size_t strideA, strideB;
    __device__ __forceinline__ bool next(int i, Unit& u) const {
        int pm, pn; if (!tile_order((long)i * G + c, nM, nN, pm, pn)) return false;
        u.pm = pm; u.pn = pn; u.aux = 0; u.nt = nt; u.A = A + (size_t)pm * strideA; u.B = B + (size_t)pn * strideB; return true;
    }
};

__device__ __forceinline__ unsigned cvt_pk_bf16(float lo, float hi) { return cvt_pk_bf16_c(lo, hi); }

template <class Epi, class Sched, int MI = 4, bool ALIGN_EPI = true, bool SP2 = true>
__device__ __forceinline__ void gemm_stream(PG8_LAS unsigned char* lds, const int tid, const int lda, const int ldb, const Sched& S, const Epi& E) {
    const int wid = __builtin_amdgcn_readfirstlane(tid >> 6), lane = tid & 63, wr = wid >> 2, wc = wid & 3, fr = lane & 15, fq = lane >> 4;
    unsigned voffA[2], voffB[2];
#pragma unroll
    for (int i = 0; i < 2; ++i) { int R, C; stage_rc(tid * 16 + i * 8192, R, C); const int Rb = Epi::PERM ? ((R & ~31) + perm32(R & 31)) : R;
        voffA[i] = (unsigned)(R * lda + C) * 2u; voffB[i] = (unsigned)(Rb * ldb + C) * 2u; }
    const size_t kstep = (size_t)(BK * 2);
    static_assert(MI == 4 || ((MI == 3 || MI == 2) && SP2), "192- and 128-row units need the SP2 schedule");
    const bool issue2 = (MI == 4) || (MI == 3 && wr == 0);
    const size_t hstepA = (size_t)(32 * MI) * lda * 2, hstepB = (size_t)HALF * ldb * 2;
    const unsigned ldsw = (unsigned)wid * 1024u;
    const int aoff = lds_byte(wr * (16 * MI) + fr, fq * 8), boff = lds_byte(wc * 32 + fr, fq * 8);
#define PG8_SA(b, h) (((b) * 2 + (h)) * HTB)
#define PG8_SB(b, h) ((4 + (b) * 2 + (h)) * HTB)
#define PG8_STAGE(bufoff, gbase, voff) do { _Pragma("unroll") for (int _i = 0; _i < 2; ++_i) \
        __builtin_amdgcn_global_load_lds((const unsigned*)((const char*)(gbase) + (voff)[_i]), (PG8_LAS unsigned*)(lds + (bufoff) + ldsw + _i * 8192), 16, 0, 0); } while (0)
#define PG8_STAGE_A(bufoff, gbase) do { __builtin_amdgcn_global_load_lds((const unsigned*)((const char*)(gbase) + voffA[0]), (PG8_LAS unsigned*)(lds + (bufoff) + ldsw), 16, 0, 0); \
        if (issue2) __builtin_amdgcn_global_load_lds((const unsigned*)((const char*)(gbase) + voffA[1]), (PG8_LAS unsigned*)(lds + (bufoff) + ldsw + 8192), 16, 0, 0); } while (0)
#define PG8_WAIT_VH(nlead, ntrail) do { if (issue2) asm volatile("s_waitcnt vmcnt(" #nlead ")" ::: "memory"); else asm volatile("s_waitcnt vmcnt(" #ntrail ")" ::: "memory"); } while (0)
#define PG8_LDA(dst, b, h) do { _Pragma("unroll") for (int m = 0; m < MI; ++m) _Pragma("unroll") for (int k = 0; k < 2; ++k) dst[m][k] = *(const PG8_LAS bf16x8*)(lds + PG8_SA(b, h) + aoff + m * 2048 + k * 1024); } while (0)
#define PG8_LDB(dst, b, h) do { _Pragma("unroll") for (int n = 0; n < 2; ++n) _Pragma("unroll") for (int k = 0; k < 2; ++k) dst[n][k] = *(const PG8_LAS bf16x8*)(lds + PG8_SB(b, h) + boff + n * 2048 + k * 1024); } while (0)
#define PG8_MMA(ai, bj, At, Bt) do { __builtin_amdgcn_s_setprio(1); _Pragma("unroll") for (int m = 0; m < MI; ++m) _Pragma("unroll") for (int n = 0; n < 2; ++n) _Pragma("unroll") for (int k = 0; k < 2; ++k) \
        acc[ai][bj][m][n] = __builtin_amdgcn_mfma_f32_16x16x32_bf16(Bt[n][k], At[m][k], acc[ai][bj][m][n], 0, 0, 0); __builtin_amdgcn_s_setprio(0); } while (0)
#define PG8_WAIT_V(n) asm volatile("s_waitcnt vmcnt(" #n ")" ::: "memory")
#define PG8_WAIT_L(n) asm volatile("s_waitcnt lgkmcnt(" #n ")" ::: "memory")
#define PG8_BAR __builtin_amdgcn_s_barrier()
#define PG8_SCHED __builtin_amdgcn_sched_barrier(0)
    Unit cur, nxt; int ui = 0;
    if (!S.next(0, cur)) return;
    f32x4 acc[2][2][MI][2];
#pragma unroll
    for (int a = 0; a < 2; ++a)
#pragma unroll
        for (int b = 0; b < 2; ++b)
#pragma unroll
            for (int m = 0; m < MI; ++m)
#pragma unroll
                for (int n = 0; n < 2; ++n) acc[a][b][m][n] = (f32x4){0.f, 0.f, 0.f, 0.f};
    bf16x8 At[MI][2], B0[2][2], B1[2][2];
    const char* cA = cur.A; const char* cB = cur.B;
    if constexpr (SP2) {
        PG8_STAGE(PG8_SB(0, 0), cB, voffB); PG8_STAGE(PG8_SB(0, 1), cB + hstepB, voffB); PG8_STAGE_A(PG8_SA(0, 0), cA); PG8_STAGE_A(PG8_SA(0, 1), cA + hstepA);
        if (wr == 1) PG8_BAR;
        PG8_WAIT_VH(2, 1); PG8_BAR;
        PG8_STAGE(PG8_SB(1, 0), cB + kstep, voffB); PG8_STAGE_A(PG8_SA(1, 0), cA + kstep); PG8_STAGE(PG8_SB(1, 1), cB + hstepB + kstep, voffB);
        PG8_WAIT_VH(6, 5); PG8_BAR;
    } else {
        PG8_STAGE(PG8_SB(0, 0), cB, voffB); PG8_STAGE(PG8_SA(0, 0), cA, voffA); PG8_STAGE(PG8_SB(0, 1), cB + hstepB, voffB); PG8_STAGE(PG8_SA(0, 1), cA + hstepA, voffA);
        if (wr == 1) PG8_BAR;
        PG8_WAIT_V(4); PG8_BAR;
        PG8_STAGE(PG8_SB(1, 0), cB + kstep, voffB); PG8_STAGE(PG8_SA(1, 0), cA + kstep, voffA); PG8_STAGE(PG8_SB(1, 1), cB + hstepB + kstep, voffB);
        PG8_WAIT_V(6); PG8_BAR;
    }
    for (;;) {
        const bool has_next = S.next(ui + 1, nxt);
        const int nt = cur.nt;
        const char* nA = has_next ? nxt.A : cA; const char* nB = has_next ? nxt.B : cB;
        for (int t = 0; t < nt; t += 2) {
            const bool last = (t == nt - 2);
            const char* a1 = cA + (size_t)(t + 1) * kstep;
            const char* a2 = last ? nA : cA + (size_t)(t + 2) * kstep; const char* b2 = last ? nB : cB + (size_t)(t + 2) * kstep;
            const char* a3 = a2 + kstep; const char* b3 = b2 + kstep;
            if constexpr (SP2) {
            PG8_LDB(B0, 0, 0); PG8_LDB(B1, 0, 1); PG8_SCHED; PG8_LDA(At, 0, 0); PG8_STAGE_A(PG8_SA(1, 1), a1 + hstepA);
            PG8_WAIT_VH(8, 6); PG8_WAIT_L(0); PG8_BAR; PG8_MMA(0, 0, At, B0); PG8_MMA(0, 1, At, B1); PG8_BAR; PG8_SCHED;
            PG8_LDA(At, 0, 1); PG8_STAGE(PG8_SB(0, 0), b2, voffB); PG8_STAGE(PG8_SB(0, 1), b2 + hstepB, voffB); PG8_STAGE_A(PG8_SA(0, 0), a2);
            PG8_WAIT_VH(8, 6); PG8_WAIT_L(0); PG8_BAR; PG8_MMA(1, 0, At, B0); PG8_MMA(1, 1, At, B1); PG8_BAR; PG8_SCHED;
            PG8_LDB(B0, 1, 0); PG8_LDB(B1, 1, 1); PG8_SCHED; PG8_LDA(At, 1, 0); PG8_STAGE_A(PG8_SA(0, 1), a2 + hstepA);
            PG8_WAIT_VH(8, 6); PG8_WAIT_L(0); PG8_BAR; PG8_MMA(0, 0, At, B0); PG8_MMA(0, 1, At, B1); PG8_BAR; PG8_SCHED;
            PG8_LDA(At, 1, 1); PG8_STAGE(PG8_SB(1, 0), b3, voffB); PG8_STAGE(PG8_SB(1, 1), b3 + hstepB, voffB); PG8_STAGE_A(PG8_SA(1, 0), a3);
            PG8_WAIT_VH(8, 6); PG8_WAIT_L(0); PG8_BAR; PG8_MMA(1, 0, At, B0); PG8_MMA(1, 1, At, B1); PG8_BAR; PG8_SCHED;
            } else {
            PG8_LDB(B0, 0, 0); PG8_SCHED; PG8_LDA(At, 0, 0); PG8_STAGE(PG8_SA(1, 1), a1 + hstepA, voffA);
            PG8_WAIT_L(8); PG8_BAR; PG8_WAIT_L(0); PG8_MMA(0, 0, At, B0); PG8_BAR; PG8_SCHED;
            PG8_LDB(B1, 0, 1); PG8_STAGE(PG8_SB(0, 0), b2, voffB);
            PG8_BAR; PG8_WAIT_L(0); PG8_MMA(0, 1, At, B1); PG8_BAR;
            PG8_LDA(At, 0, 1); PG8_STAGE(PG8_SA(0, 0), a2, voffA);
            PG8_BAR; PG8_WAIT_L(0); PG8_MMA(1, 0, At, B0); PG8_BAR; PG8_SCHED;
            PG8_STAGE(PG8_SB(0, 1), b2 + hstepB, voffB);
            PG8_WAIT_V(6); PG8_BAR; PG8_MMA(1, 1, At, B1); PG8_BAR;
            PG8_LDB(B0, 1, 0); PG8_SCHED; PG8_LDA(At, 1, 0); PG8_STAGE(PG8_SA(0, 1), a2 + hstepA, voffA);
            PG8_WAIT_L(8); PG8_BAR; PG8_WAIT_L(0); PG8_MMA(0, 0, At, B0); PG8_BAR; PG8_SCHED;
            PG8_LDB(B1, 1, 1); PG8_STAGE(PG8_SB(1, 0), b3, voffB);
            PG8_BAR; PG8_WAIT_L(0); PG8_MMA(0, 1, At, B1); PG8_BAR;
            PG8_LDA(At, 1, 1); PG8_STAGE(PG8_SA(1, 0), a3, voffA);
            PG8_BAR; PG8_WAIT_L(0); PG8_MMA(1, 0, At, B0); PG8_BAR; PG8_SCHED;
            PG8_STAGE(PG8_SB(1, 1), b3 + hstepB, voffB);
            PG8_WAIT_V(6); PG8_BAR; PG8_MMA(1, 1, At, B1); PG8_BAR;
            }
        }
        if constexpr (ALIGN_EPI) { if (wr == 0) PG8_BAR; }
        E(acc, cur, wr, wc, fr, fq);
        if (!has_next) break;
#pragma unroll
        for (int a = 0; a < 2; ++a)
#pragma unroll
            for (int b = 0; b < 2; ++b)
#pragma unroll
                for (int m = 0; m < MI; ++m)
#pragma unroll
                    for (int n = 0; n < 2; ++n) acc[a][b][m][n] = (f32x4){0.f, 0.f, 0.f, 0.f};
        cur = nxt; cA = nA; cB = nB; ++ui;
        if constexpr (ALIGN_EPI) { if (wr == 1) PG8_BAR; }
    }
    PG8_WAIT_V(0);
    if constexpr (!ALIGN_EPI) { if (wr == 0) PG8_BAR; }
    PG8_BAR;
#undef PG8_SA
#undef PG8_SB
#undef PG8_STAGE
#undef PG8_STAGE_A
#undef PG8_WAIT_VH
#undef PG8_LDA
#undef PG8_LDB
#undef PG8_MMA
#undef PG8_WAIT_V
#undef PG8_WAIT_L
#undef PG8_BAR
#undef PG8_SCHED
}
}

constexpr int NL = 4, DM = 2048, MTOK = 6144, MCTX = 4096, DIN_ = 6144, NGATE = 8192, NIG = 14336, DFF = 5632, NUP = 11264, KBR = 2560;
constexpr int N_ADA = 12288;
constexpr float EPS_ = 1e-6f;
constexpr size_t OUT_Y = 0, OUT_NK = (size_t)MTOK * DM, OUT_NV = OUT_NK + (size_t)16 * 4 * 256 * 1024;
constexpr size_t OUT_TOTAL = OUT_NV + (size_t)16 * 4 * 256 * 1024;

constexpr size_t al256(size_t x) { return (x + 255) & ~(size_t)255; }
constexpr size_t WS_CTL = 0, CTL_ZERO_BYTES = 1u << 20;
constexpr size_t WS_MOD = WS_CTL + CTL_ZERO_BYTES;
constexpr size_t WS_PARTMOD = al256(WS_MOD + (size_t)NL * 3 * N_ADA * 4);
constexpr size_t WS_LAM = al256(WS_PARTMOD + (size_t)NL * 32 * 3 * N_ADA * 4);
constexpr size_t WS_ROPE = al256(WS_LAM + 256);
constexpr size_t WS_TWC = al256(WS_ROPE + 64 * 32 * 2 * 4);
constexpr size_t WS_TW256 = al256(WS_TWC + 512 * 256 * 2);
constexpr size_t WS_TW1024 = al256(WS_TW256 + 256 * 512 * 2);
constexpr size_t WS_WIG = al256(WS_TW1024 + 1024 * 2048 * 2);
constexpr size_t SZ_WIG = (size_t)NIG * DM * 2;
constexpr size_t WS_WBR = al256(WS_WIG + NL * SZ_WIG);
constexpr size_t SZ_WBR = (size_t)DM * KBR * 2;
constexpr size_t WS_WO = al256(WS_WBR + NL * SZ_WBR);
constexpr size_t SZ_WO = (size_t)DM * DM * 2;
constexpr size_t WS_WUP = al256(WS_WO + NL * SZ_WO);
constexpr size_t SZ_WUP = (size_t)NUP * DM * 2;
constexpr size_t WS_WDN = al256(WS_WUP + NL * SZ_WUP);
constexpr size_t SZ_WDN = (size_t)DM * DFF * 2;
constexpr size_t WS_H = al256(WS_WDN + NL * SZ_WDN);
constexpr size_t WS_PROJ = al256(WS_H + (size_t)MTOK * DM * 2);
constexpr size_t WS_GATES = al256(WS_PROJ + (size_t)MTOK * DIN_ * 2);
constexpr size_t WS_KCTX = al256(WS_GATES + (size_t)MTOK * NGATE);
constexpr size_t WS_VCTX = al256(WS_KCTX + (size_t)MCTX * 1024 * 2);
constexpr size_t WS_KLAT = al256(WS_VCTX + (size_t)MCTX * 1024 * 2);
constexpr size_t SZ_KLAT = (size_t)2 * 1536 * 1024 * 2;
constexpr size_t WS_VLAT = al256(WS_KLAT + NL * SZ_KLAT);
constexpr size_t WS_AO = al256(WS_VLAT + NL * SZ_KLAT);
constexpr size_t WS_ML = al256(WS_AO + (size_t)2 * MTOK * 2048 * 2);
constexpr size_t WS_BR = al256(WS_ML + (size_t)2 * MTOK * 32 * 4);
constexpr size_t WS_PQC = al256(WS_BR + (size_t)MTOK * KBR * 2);
constexpr size_t WS_PQL = al256(WS_PQC + (size_t)16 * 512 * 512 * 2);
constexpr size_t WS_PART = al256(WS_PQL + (size_t)2 * 512 * 2048 * 2);
constexpr size_t WS_MERGED = al256(WS_PART + (size_t)3 * 192 * 32 * 512 * 8);
constexpr size_t WS_MIX = al256(WS_MERGED + (size_t)MTOK * DM * 2);
constexpr size_t WS_SSQ = al256(WS_MIX + (size_t)MTOK * DM * 4);
constexpr size_t WS_FACT = al256(WS_SSQ + (size_t)MTOK * 32 * 4);
constexpr size_t WS_FP = al256(WS_FACT + (size_t)MTOK * DFF * 2);
constexpr size_t WS_END = al256(WS_FP + (size_t)4 * 2048 * 512 * 4);

constexpr int CW_BAR = 4096;

constexpr int RING_BYTES = 131072;
constexpr int LDSCTL_OFF = RING_BYTES, MISC_OFF = LDSCTL_OFF + 320;
constexpr int LDS_BYTES = 147456;

namespace pg8 {
__constant__ unsigned char G1_PN[56] = {24, 25, 0, 8, 26, 27, 1, 28, 29, 2, 9, 30, 31, 3, 32, 33, 4, 10, 34, 35, 5, 36, 37, 6, 11, 38, 39, 7, 40, 41, 16, 12, 42, 43, 17, 44, 45, 18, 13, 46, 47, 19, 48, 49, 20, 14, 50, 51, 21, 52, 53, 22, 15, 54, 55, 23};
struct SchedMain {
    int nM, nN, G, c, nfull; const char* A; const char* B; size_t lda2, ldb2; const unsigned char* perm;
    __device__ __forceinline__ bool next(int i, Unit& u) const {
        const long L = (long)i * G + c; if (L >= nfull) return false;
        int pm, pn; tile_order(L, nM, nN, pm, pn); if (perm) pn = perm[pn];
        u.pm = pm; u.pn = pn; u.aux = 0; u.nt = 32; u.A = A + (size_t)pm * 256 * lda2; u.B = B + (size_t)pn * 256 * ldb2; return true;
    }
};
struct SchedLeft {
    int nM, nN, G, c, nfull; const char* A; const char* B; size_t lda2, ldb2; const unsigned char* perm;
    __device__ __forceinline__ bool next(int i, Unit& u) const {
        const int nunits = 2 * (nM * nN - nfull); if (i != 0 || nunits <= 0) return false;
        int j; if (nunits <= G && G % nunits == 0) { const int st = G / nunits; if (c % st) return false; j = c / st; } else { j = c; if (j >= nunits) return false; }
        int pm, pn; tile_order((long)nfull + (j >> 1), nM, nN, pm, pn); if (perm) pn = perm[pn];
        u.pm = pm * 2 + (j & 1); u.pn = pn; u.aux = 0; u.nt = 32; u.A = A + (size_t)(pm * 256 + (j & 1) * 128) * lda2; u.B = B + (size_t)pn * 256 * ldb2; return true;
    }
};
__device__ __forceinline__ unsigned pack_u8x4(float a, float b, float c, float d) {
    const unsigned ua = (unsigned)(a * 255.0f + 0.5f), ub = (unsigned)(b * 255.0f + 0.5f), uc = (unsigned)(c * 255.0f + 0.5f), ud = (unsigned)(d * 255.0f + 0.5f);
    return ua | (ub << 8) | (uc << 16) | (ud << 24);
}
template <int MI> struct EpiG1 {
    static constexpr bool PERM = true;
    static constexpr int TM = 64 * MI, TH = 32 * MI, TW = 16 * MI;
    bf16_t* proj; unsigned char* gates; bf16_t* kctx; bf16_t* vctx; bf16_t* klat; bf16_t* vlat; float* newk; float* newv; const float* bgate;
    __device__ __forceinline__ void operator()(const f32x4 (&acc)[2][2][MI][2], const Unit& u, int wr, int wc, int fr, int fq) const {
        const int pm = u.pm, pn = u.pn, cl0 = wc * 32 + 8 * fq;
        if (pn >= 24) {
            const int gc0 = (pn - 24) * 256 + cl0;
            f32x4 bv[2][2];
#pragma unroll
            for (int bj = 0; bj < 2; ++bj)
#pragma unroll
                for (int n = 0; n < 2; ++n) bv[bj][n] = *(const f32x4*)(bgate + gc0 + bj * HALF + 4 * n);
#pragma unroll
            for (int ai = 0; ai < 2; ++ai)
#pragma unroll
                for (int m = 0; m < MI; ++m) { unsigned char* rowp = gates + (size_t)(pm * TM + ai * TH + wr * TW + m * 16 + fr) * NGATE + gc0;
#pragma unroll
                    for (int bj = 0; bj < 2; ++bj) { const f32x4 v0 = acc[ai][bj][m][0] + bv[bj][0], v1 = acc[ai][bj][m][1] + bv[bj][1];
                        u32x2 w; w.x = pack_u8x4(sigmoid_f(v0[0]), sigmoid_f(v0[1]), sigmoid_f(v0[2]), sigmoid_f(v0[3])); w.y = pack_u8x4(sigmoid_f(v1[0]), sigmoid_f(v1[1]), sigmoid_f(v1[2]), sigmoid_f(v1[3]));
                        *(u32x2*)(rowp + bj * HALF) = w; } }
        } else if (pn >= 8 && pn < 16) {
            const bool isv = pn >= 12; const int c0 = (pn - (isv ? 12 : 8)) * 256 + cl0;
            const int r0 = pm * TM; bf16_t* base; float* ob = nullptr;
            if (r0 < MCTX) { base = (isv ? vctx : kctx) + (size_t)r0 * 1024; ob = (isv ? newv : newk) + ((size_t)(r0 >> 8) * 4 * 256 + (r0 & 255)) * 1024; }
            else { const int b = (r0 - MCTX) >> 10, t = (r0 - MCTX) & 1023; base = (isv ? vlat : klat) + (size_t)(b * 1536 + 512 + t) * 1024; }
#pragma unroll
            for (int ai = 0; ai < 2; ++ai)
#pragma unroll
                for (int m = 0; m < MI; ++m) { const size_t ro = (size_t)(ai * TH + wr * TW + m * 16 + fr) * 1024 + c0;
#pragma unroll
                    for (int bj = 0; bj < 2; ++bj) { const f32x4 v0 = acc[ai][bj][m][0], v1 = acc[ai][bj][m][1];
                        u32x4 w; w.x = cvt_pk_bf16(v0[0], v0[1]); w.y = cvt_pk_bf16(v0[2], v0[3]); w.z = cvt_pk_bf16(v1[0], v1[1]); w.w = cvt_pk_bf16(v1[2], v1[3]);
                        *(u32x4*)(base + ro + bj * HALF) = w;
                        if (ob) { *(f32x4*)(ob + ro + bj * HALF) = v0; *(f32x4*)(ob + ro + bj * HALF + 4) = v1; } } }
        } else {
#pragma unroll
            for (int ai = 0; ai < 2; ++ai)
#pragma unroll
                for (int m = 0; m < MI; ++m) { bf16_t* rowp = proj + (size_t)(pm * TM + ai * TH + wr * TW + m * 16 + fr) * DIN_ + pn * 256 + cl0;
#pragma unroll
                    for (int bj = 0; bj < 2; ++bj) { const f32x4 v0 = acc[ai][bj][m][0], v1 = acc[ai][bj][m][1];
                        u32x4 w; w.x = cvt_pk_bf16(v0[0], v0[1]); w.y = cvt_pk_bf16(v0[2], v0[3]); w.z = cvt_pk_bf16(v1[0], v1[1]); w.w = cvt_pk_bf16(v1[2], v1[3]);
                        *(u32x4*)(rowp + bj * HALF) = w; } }
        }
    }
};
struct EpiBf16 {
    static constexpr bool PERM = true;
    bf16_t* O; int ldc; int coloff;
    __device__ __forceinline__ void operator()(const f32x4 (&acc)[2][2][4][2], const Unit& u, int wr, int wc, int fr, int fq) const {
#pragma unroll
        for (int ai = 0; ai < 2; ++ai)
#pragma unroll
            for (int m = 0; m < 4; ++m) { bf16_t* rowp = O + (size_t)(u.pm * 256 + ai * HALF + m * 16 + wr * 64 + fr) * ldc + coloff + u.pn * 256 + wc * 32 + 8 * fq;
#pragma unroll
                for (int bj = 0; bj < 2; ++bj) { const f32x4 v0 = acc[ai][bj][m][0], v1 = acc[ai][bj][m][1];
                    u32x4 w; w.x = cvt_pk_bf16(v0[0], v0[1]); w.y = cvt_pk_bf16(v0[2], v0[3]); w.z = cvt_pk_bf16(v1[0], v1[1]); w.w = cvt_pk_bf16(v1[2], v1[3]);
                    *(u32x4*)(rowp + bj * HALF) = w; } }
    }
};
struct EpiF1 {
    static constexpr bool PERM = true;
    bf16_t* pqc; bf16_t* pql;
    __device__ __forceinline__ void operator()(const f32x4 (&acc)[2][2][4][2], const Unit& u, int wr, int wc, int fr, int fq) const {
        const int g = 2 * u.aux + u.pm, pn = u.pn; bf16_t* base; int T, tl0;
        if (pn < 16) { base = pqc + (size_t)pn * 512 * 512; T = 256; tl0 = 0; } else { base = pql + (size_t)((pn - 16) >> 2) * 512 * 2048; T = 1024; tl0 = ((pn - 16) & 3) * 256; }
#pragma unroll
        for (int ai = 0; ai < 2; ++ai)
#pragma unroll
            for (int m = 0; m < 4; ++m) { const int j = wr * 64 + m * 16 + fr; bf16_t* rowp = base + (size_t)(g * 128 + j) * (2 * T) + ai * T + tl0 + wc * 32 + 8 * fq;
#pragma unroll
                for (int bj = 0; bj < 2; ++bj) { const f32x4 v0 = acc[ai][bj][m][0], v1 = acc[ai][bj][m][1];
                    u32x4 w; w.x = cvt_pk_bf16(v0[0], v0[1]); w.y = cvt_pk_bf16(v0[2], v0[3]); w.z = cvt_pk_bf16(v1[0], v1[1]); w.w = cvt_pk_bf16(v1[2], v1[3]);
                    *(u32x4*)(rowp + bj * HALF) = w; } }
    }
};
template <int MI> struct EpiG2 {
    static constexpr bool PERM = false;
    const unsigned char* gates; unsigned* part; bf16_t* merged;
    static constexpr int TM = 64 * MI, TH = 32 * MI, TW = 16 * MI, NFR = 8 * MI; static constexpr size_t SLAB = (size_t)(MTOK / TM) * 8 * NFR * 512 * 2;
    __device__ __forceinline__ void operator()(const f32x4 (&acc)[2][2][MI][2], const Unit& u, int wr, int wc, int fr, int fq) const {
        const int i = u.aux, tile = u.pm * 8 + u.pn, tid = (wr * 4 + wc) * 64 + fq * 16 + fr;
        unsigned* pb = part + ((size_t)tile * NFR * 512 + tid) * 2;
#pragma unroll
        for (int ai = 0; ai < 2; ++ai) {
            unsigned gw[MI][2][2];
#pragma unroll
            for (int m = 0; m < MI; ++m) { const unsigned char* gp = gates + (size_t)(u.pm * TM + ai * TH + m * 16 + wr * TW + fr) * NGATE + i * 2048 + u.pn * 256 + wc * 32 + 4 * fq;
#pragma unroll
                for (int bj = 0; bj < 2; ++bj)
#pragma unroll
                    for (int n = 0; n < 2; ++n) gw[m][bj][n] = *(const unsigned*)(gp + bj * HALF + n * 16); }
#pragma unroll
            for (int m = 0; m < MI; ++m) { const size_t row = (size_t)(u.pm * TM + ai * TH + m * 16 + wr * TW + fr);
                u32x2 z[3][2][2];
                if (i == 3) {
#pragma unroll
                    for (int bj = 0; bj < 2; ++bj)
#pragma unroll
                        for (int n = 0; n < 2; ++n) { const unsigned* p = pb + (size_t)((((ai * MI + m) * 2 + bj) * 2 + n) * 512) * 2;
                            z[0][bj][n] = *(const u32x2*)p; z[1][bj][n] = *(const u32x2*)(p + SLAB); z[2][bj][n] = *(const u32x2*)(p + 2 * SLAB); }
                }
#pragma unroll
                for (int bj = 0; bj < 2; ++bj)
#pragma unroll
                    for (int n = 0; n < 2; ++n) { const int col = u.pn * 256 + bj * HALF + wc * 32 + n * 16 + 4 * fq;
                        f32x4 v = acc[ai][bj][m][n]; const unsigned g = gw[m][bj][n]; constexpr float K255 = 1.0f / 255.0f;
                        v[0] *= (float)(g & 255u) * K255; v[1] *= (float)((g >> 8) & 255u) * K255; v[2] *= (float)((g >> 16) & 255u) * K255; v[3] *= (float)(g >> 24) * K255;
                        unsigned* p = pb + (size_t)((((ai * MI + m) * 2 + bj) * 2 + n) * 512) * 2;
                        if (i == 3) {
#pragma unroll
                            for (int k = 0; k < 3; ++k) { const u32x2 zz = z[k][bj][n]; v[0] += bf_lo(zz.x); v[1] += bf_hi(zz.x); v[2] += bf_lo(zz.y); v[3] += bf_hi(zz.y); }
                            u32x2 w; w.x = cvt_pk_bf16(v[0], v[1]); w.y = cvt_pk_bf16(v[2], v[3]); *(u32x2*)(merged + row * DM + col) = w; }
                        else { u32x2 w; w.x = cvt_pk_bf16(v[0], v[1]); w.y = cvt_pk_bf16(v[2], v[3]); *(u32x2*)(p + (size_t)i * SLAB) = w; } } }
        }
    }
};
template <int MI> struct EpiSsq {
    static constexpr bool PERM = false;
    float* out; float* ssq;
    __device__ __forceinline__ void operator()(const f32x4 (&acc)[2][2][MI][2], const Unit& u, int wr, int wc, int fr, int fq) const {
#pragma unroll
        for (int ai = 0; ai < 2; ++ai)
#pragma unroll
            for (int m = 0; m < MI; ++m) { const size_t row = (size_t)(u.pm * (64 * MI) + ai * (32 * MI) + m * 16 + wr * (16 * MI) + fr); float s = 0.f;
#pragma unroll
                for (int bj = 0; bj < 2; ++bj)
#pragma unroll
                    for (int n = 0; n < 2; ++n) { const int col = u.pn * 256 + bj * HALF + wc * 32 + n * 16 + 4 * fq; const f32x4 v = acc[ai][bj][m][n];
                        *(f32x4*)(out + row * DM + col) = v; s += (v[0] * v[0] + v[1] * v[1]) + (v[2] * v[2] + v[3] * v[3]); }
                s += __shfl_xor(s, 16); s += __shfl_xor(s, 32);
                if (fq == 0) ssq[((size_t)u.pn * MTOK + row) * 4 + wc] = s; }
    }
};
template <int MI> struct EpiSwiGLU {
    static constexpr bool PERM = false;
    bf16_t* fact;
    __device__ __forceinline__ void operator()(const f32x4 (&acc)[2][2][MI][2], const Unit& u, int wr, int wc, int fr, int fq) const {
#pragma unroll
        for (int ai = 0; ai < 2; ++ai)
#pragma unroll
            for (int m = 0; m < MI; ++m) { const size_t row = (size_t)(u.pm * (64 * MI) + ai * (32 * MI) + m * 16 + wr * (16 * MI) + fr);
#pragma unroll
                for (int bj = 0; bj < 2; ++bj) { const f32x4 up = acc[ai][bj][m][0], gt = acc[ai][bj][m][1]; const int j = u.pn * 128 + (4 * bj + wc) * 16 + 4 * fq;
                    u32x2 w; w.x = cvt_pk_bf16(gt[0] * sigmoid_f(gt[0]) * up[0], gt[1] * sigmoid_f(gt[1]) * up[1]); w.y = cvt_pk_bf16(gt[2] * sigmoid_f(gt[2]) * up[2], gt[3] * sigmoid_f(gt[3]) * up[3]);
                    *(u32x2*)(fact + row * DFF + j) = w; } }
    }
};
template <int MI> struct SchedG2 {
    int G, c; const char* A; const char* B;
    __device__ __forceinline__ bool next(int i, Unit& u) const {
        int pm, pn; if (!tile_order((long)(i >> 2) * G + c, MTOK / (64 * MI), 8, pm, pn)) return false;
        const int br = i & 3, koff = br == 0 ? 0 : (br == 1 ? 512 : (br == 2 ? 1536 : 2048));
        u.pm = pm; u.pn = pn; u.aux = br; u.nt = br == 1 ? 16 : 8;
        u.A = A + ((size_t)pm * (64 * MI) * KBR + koff) * 2; u.B = B + ((size_t)pn * 256 * KBR + koff) * 2; return true;
    }
};
struct SchedF1 {
    int G, c, nt; const char* A; const char* B;
    __device__ __forceinline__ bool next(int i, Unit& u) const {
        const int L = i * G + c; if (L >= 96) return false;
        const int p = L / 48, r = L % 48; u.pm = r & 1; u.pn = r >> 1; u.aux = p; u.nt = nt;
        u.A = A + (size_t)u.pm * 256 * 256 * 2; u.B = B + ((size_t)(u.pn * 256) * DIN_ + 5632 + p * 256) * 2; return true;
    }
};
struct SchedF2L {
    int G, c; const char* A; const char* B;
    __device__ __forceinline__ bool next(int i, Unit& u) const {
        const int L = i * G + c; if (L >= 64) return false;
        const int ks = L & 3, t = L >> 2, b = t >> 3, pm = (t >> 1) & 3, pn = t & 1; u.pm = b * 4 + pm; u.pn = pn; u.aux = ks; u.nt = 8;
        u.A = A + ((size_t)pm * 256 * 2048 + ks * 512) * 2; u.B = B + ((size_t)b * 512 * 2048 + (size_t)pn * 256 * 2048 + ks * 512) * 2; return true;
    }
};
struct EpiF2P {
    static constexpr bool PERM = false;
    float* fp;
    __device__ __forceinline__ void operator()(const f32x4 (&acc)[2][2][4][2], const Unit& u, int wr, int wc, int fr, int fq) const {
        float* base = fp + (size_t)u.aux * 2048 * 512;
#pragma unroll
        for (int ai = 0; ai < 2; ++ai)
#pragma unroll
            for (int m = 0; m < 4; ++m) { float* rowp = base + (size_t)(u.pm * 256 + ai * HALF + m * 16 + wr * 64 + fr) * 512 + u.pn * 256 + wc * 32 + 4 * fq;
#pragma unroll
                for (int bj = 0; bj < 2; ++bj)
#pragma unroll
                    for (int n = 0; n < 2; ++n) *(f32x4*)(rowp + bj * HALF + n * 16) = acc[ai][bj][m][n]; }
    }
};
struct SchedF2C {
    int G, c; const char* A; const char* B;
    __device__ __forceinline__ bool next(int i, Unit& u) const {
        const int idx = i * G + (c + G - (64 % G)) % G; if (idx >= 32) return false;
        const int s = idx >> 1, pn = idx & 1; u.pm = s; u.pn = pn; u.aux = 0; u.nt = 8;
        u.A = A; u.B = B + ((size_t)s * 512 * 512 + (size_t)pn * 256 * 512) * 2; return true;
    }
};
}

namespace att {
constexpr int D = 128, NW = 8, QBLK = 32, KVBLK = 64;
constexpr float SCALE = 0.088388347648318440f;
constexpr float THR = 8.f;
constexpr int LDQ = 6144, LDK = 1024, LDO = 2048;
constexpr size_t SHM_V = KVBLK * D * 2, SHM_K = KVBLK * D * 2, SHM_ATTN = 2 * SHM_V + 2 * SHM_K + NW * 64 * 4;
#define KSWZ(row, colB) ((row) * 256 + ((colB) ^ (((row) & 7) << 4)))
#define SBAR() __builtin_amdgcn_sched_barrier(0)
__device__ __forceinline__ int crow(int r, int hi) { return (r & 3) + 8 * (r >> 2) + 4 * hi; }
__device__ __forceinline__ unsigned cvtpk(float lo, float hi) { return cvt_pk_bf16_c(lo, hi); }

__device__ __forceinline__ void partialSM(f32x16& p0, f32x16& p1, float& m_reg, float& mn, float& alpha) {
  constexpr float C = SCALE * 1.4426950408889634f;
  float pmax = p0[0];
#pragma unroll
  for (int r = 1; r < 16; ++r) pmax = fmaxf(pmax, p0[r]);
#pragma unroll
  for (int r = 0; r < 16; ++r) pmax = fmaxf(pmax, p1[r]);
  { auto rr = __builtin_amdgcn_permlane32_swap(__float_as_uint(pmax), __float_as_uint(pmax), false, false);
    pmax = fmaxf(__uint_as_float(rr[0]), __uint_as_float(rr[1])); }
  if (__builtin_expect(__all(pmax - m_reg <= THR / SCALE), 1)) { mn = m_reg; alpha = 1.f; }
  else { mn = fmaxf(m_reg, pmax); alpha = __builtin_amdgcn_exp2f((m_reg - mn) * C); m_reg = mn; }
  float mnC = -mn * C;
#pragma unroll
  for (int r = 0; r < 16; ++r) p0[r] = fmaf(p0[r], C, mnC);
#pragma unroll
  for (int r = 0; r < 16; ++r) p1[r] = fmaf(p1[r], C, mnC);
#pragma unroll
  for (int r = 0; r < 16; ++r) p0[r] = __builtin_amdgcn_exp2f(p0[r]);
}
__device__ __forceinline__ void finishSM(f32x16& p0, f32x16& p1, float alpha, float& l_reg, bf16x8& pa0, bf16x8& pa1, bf16x8& pa2, bf16x8& pa3) {
#pragma unroll
  for (int r = 0; r < 16; ++r) p1[r] = __builtin_amdgcn_exp2f(p1[r]);
  float ps = 0;
#pragma unroll
  for (int r = 0; r < 16; ++r) ps += p0[r];
#pragma unroll
  for (int r = 0; r < 16; ++r) ps += p1[r];
  { auto rr = __builtin_amdgcn_permlane32_swap(__float_as_uint(ps), __float_as_uint(ps), false, false);
    ps = __uint_as_float(rr[0]) + __uint_as_float(rr[1]); }
  l_reg = l_reg * alpha + ps;
#define PK4(P, BASE, OUT) do { unsigned a0 = cvtpk(P[BASE + 0], P[BASE + 1]), a1 = cvtpk(P[BASE + 2], P[BASE + 3]);   \
    unsigned b0 = cvtpk(P[BASE + 4], P[BASE + 5]), b1 = cvtpk(P[BASE + 6], P[BASE + 7]);                              \
    auto r0 = __builtin_amdgcn_permlane32_swap(a0, b0, false, false); auto r1 = __builtin_amdgcn_permlane32_swap(a1, b1, false, false); \
    v4u w = {r0[0], r1[0], r0[1], r1[1]}; OUT = __builtin_bit_cast(bf16x8, w); } while (0)
  PK4(p0, 0, pa0); PK4(p0, 8, pa1); PK4(p1, 0, pa2); PK4(p1, 8, pa3);
#undef PK4
}
__device__ __forceinline__ void qkt(f32x16& p0, f32x16& p1, const LAS char* Ks, const bf16x8* qr, int r32, int hi) {
  p0 = f32x16{}; p1 = f32x16{};
#pragma unroll
  for (int d0 = 0; d0 < 8; ++d0) { int cb = (d0 * 16 + hi * 8) * 2;
    bf16x8 b0 = *(const LAS bf16x8*)(Ks + KSWZ(r32, cb));
    bf16x8 b1 = *(const LAS bf16x8*)(Ks + KSWZ(32 + r32, cb));
    p0 = __builtin_amdgcn_mfma_f32_32x32x16_bf16(b0, qr[d0], p0, 0, 0, 0);
    p1 = __builtin_amdgcn_mfma_f32_32x32x16_bf16(b1, qr[d0], p1, 0, 0, 0); }
}
__device__ __forceinline__ int v_st(int k, int c) { const int kk = (k & ~0xC) | ((k & 4) << 1) | ((k & 8) >> 1); return ((kk >> 3) * 4 + (c >> 5)) * 512 + ((kk & 7) * 32 + (c & 31)) * 2; }
__device__ __forceinline__ int v_rd_base(int lane) { return ((lane & 3) << 3) | (((lane >> 2) & 3) << 6) | (((lane >> 4) & 1) << 5) | (((lane >> 5) & 1) << 8); }
constexpr int v_rd_off(int d0, int ks, int half) { return d0 * 512 + ks * 4096 + half * 2048; }
template <int OFF> __device__ __forceinline__ s16x4 tr_read(int vb) {
  s16x4 r; asm volatile("ds_read_b64_tr_b16 %0, %1 offset:%2" : "=&v"(r) : "v"(vb), "i"(OFF) : "memory"); return r;
}
template <int D0> __device__ __forceinline__ void pv_one(f32x16& od, int vb, bf16x8 pa0, bf16x8 pa1, bf16x8 pa2, bf16x8 pa3) {
  const s16x4 l0 = tr_read<v_rd_off(D0, 0, 0)>(vb), h0 = tr_read<v_rd_off(D0, 0, 1)>(vb), l1 = tr_read<v_rd_off(D0, 1, 0)>(vb), h1 = tr_read<v_rd_off(D0, 1, 1)>(vb);
  const s16x4 l2 = tr_read<v_rd_off(D0, 2, 0)>(vb), h2 = tr_read<v_rd_off(D0, 2, 1)>(vb), l3 = tr_read<v_rd_off(D0, 3, 0)>(vb), h3 = tr_read<v_rd_off(D0, 3, 1)>(vb);
  asm volatile("s_waitcnt lgkmcnt(0)" ::: "memory"); SBAR();
#define PK(L, H) (bf16x8){L[0], L[1], L[2], L[3], H[0], H[1], H[2], H[3]}
  od = __builtin_amdgcn_mfma_f32_32x32x16_bf16(pa0, PK(l0, h0), od, 0, 0, 0);
  od = __builtin_amdgcn_mfma_f32_32x32x16_bf16(pa1, PK(l1, h1), od, 0, 0, 0);
  od = __builtin_amdgcn_mfma_f32_32x32x16_bf16(pa2, PK(l2, h2), od, 0, 0, 0);
  od = __builtin_amdgcn_mfma_f32_32x32x16_bf16(pa3, PK(l3, h3), od, 0, 0, 0);
#undef PK
}
__device__ __forceinline__ void pv_d0(f32x16* o, int vb, bf16x8 pa0, bf16x8 pa1, bf16x8 pa2, bf16x8 pa3) {
  pv_one<0>(o[0], vb, pa0, pa1, pa2, pa3); pv_one<1>(o[1], vb, pa0, pa1, pa2, pa3); pv_one<2>(o[2], vb, pa0, pa1, pa2, pa3); pv_one<3>(o[3], vb, pa0, pa1, pa2, pa3);
}

__device__ __forceinline__ void attn_unit(const bf16* __restrict__ Qb, const bf16* __restrict__ Kh, const bf16* __restrict__ Vh,
                                          bf16* __restrict__ Ob, float* __restrict__ MLb, int seq, LAS char* lds, const int tid) {
  const int wid = tid >> 6, lane = tid & 63, r32 = lane & 31, hi = lane >> 5;
  LAS char* V_lds = lds; LAS char* K_lds = lds + 2 * SHM_V;
  LAS float* wsf = (LAS float*)(lds + 2 * SHM_V + 2 * SHM_K) + wid * 64; LAS float* al_l = wsf + 32;
  float m_reg = -1e30f, l_reg = 0; f32x16 o[4] = {}; bf16x8 qr[8];
  const int qoff = (wid * QBLK + r32) * LDQ + hi * 8;
#pragma unroll
  for (int d0 = 0; d0 < 8; ++d0) qr[d0] = *(const bf16x8*)(Qb + qoff + d0 * 16);
  const int sr = tid >> 4, sc = (tid & 15) * 8, vst0 = v_st(sr, sc), vst1 = v_st(32 + sr, sc);
  const int vb0 = (int)(unsigned)(uintptr_t)V_lds + v_rd_base(lane);
  const int kvoff = sr * LDK + sc;
  struct { bf16x8 vs0, vs1, ks0, ks1; } sr_[2];
#define SLOAD(i, k0) do { const bf16* Vt_ = Vh + (size_t)(k0) * LDK; const bf16* Kt_ = Kh + (size_t)(k0) * LDK; \
    sr_[i].vs0 = *(const bf16x8*)(Vt_ + kvoff); sr_[i].vs1 = *(const bf16x8*)(Vt_ + 32 * LDK + kvoff); \
    sr_[i].ks0 = *(const bf16x8*)(Kt_ + kvoff); sr_[i].ks1 = *(const bf16x8*)(Kt_ + 32 * LDK + kvoff); } while (0)
#define SWRITE(b, i) do { *(LAS bf16x8*)(V_lds + (b) * SHM_V + vst0) = sr_[i].vs0;          \
    *(LAS bf16x8*)(V_lds + (b) * SHM_V + vst1) = sr_[i].vs1; int kc = sc * 2;               \
    *(LAS bf16x8*)(K_lds + (b) * SHM_K + KSWZ(sr, kc)) = sr_[i].ks0;                       \
    *(LAS bf16x8*)(K_lds + (b) * SHM_K + KSWZ(32 + sr, kc)) = sr_[i].ks1; } while (0)
#define SWAIT() asm volatile("s_waitcnt vmcnt(4)" ::: "memory")
#define RESC(a) do { if (__any((a) < 1.f)) { if (hi == 0) al_l[r32] = (a); asm volatile("s_waitcnt lgkmcnt(0)" ::: "memory"); \
    _Pragma("unroll") for (int d = 0; d < 4; ++d) _Pragma("unroll") for (int r = 0; r < 16; ++r) o[d][r] *= al_l[crow(r, hi)]; } } while (0)
  f32x16 pA0, pA1, pB0, pB1; float mnA, mnB, alA, alB; bf16x8 pa0, pa1, pa2, pa3; const int NT = seq / KVBLK;
  constexpr int SE = 0, SO = 1;
  SLOAD(SE, 0); asm volatile("s_waitcnt vmcnt(0)" ::: "memory"); SWRITE(0, SE); __syncthreads();
  qkt(pA0, pA1, K_lds, qr, r32, hi); partialSM(pA0, pA1, m_reg, mnA, alA);
  SLOAD(SO, KVBLK); if (2 < NT) SLOAD(SE, 2 * KVBLK);
  SWAIT(); SWRITE(1, SO); __syncthreads();
  for (int j = 1; j + 1 < NT; j += 2) {
    SBAR(); qkt(pB0, pB1, K_lds + SHM_K, qr, r32, hi);
    finishSM(pA0, pA1, alA, l_reg, pa0, pa1, pa2, pa3); SBAR();
    SLOAD(SO, (j + 2) * KVBLK); SBAR();
    pv_d0(o, vb0, pa0, pa1, pa2, pa3); partialSM(pB0, pB1, m_reg, mnB, alB);
    __syncthreads(); SWAIT(); SWRITE(0, SE);
    RESC(alB); __syncthreads();
    SBAR(); qkt(pA0, pA1, K_lds, qr, r32, hi);
    finishSM(pB0, pB1, alB, l_reg, pa0, pa1, pa2, pa3); SBAR();
    if (j + 3 < NT) SLOAD(SE, (j + 3) * KVBLK); SBAR();
    pv_d0(o, vb0 + (int)SHM_V, pa0, pa1, pa2, pa3); partialSM(pA0, pA1, m_reg, mnA, alA);
    __syncthreads(); SWAIT(); SWRITE(1, SO);
    RESC(alA); __syncthreads();
  }
  SBAR(); qkt(pB0, pB1, K_lds + SHM_K, qr, r32, hi);
  finishSM(pA0, pA1, alA, l_reg, pa0, pa1, pa2, pa3); SBAR();
  pv_d0(o, vb0, pa0, pa1, pa2, pa3); partialSM(pB0, pB1, m_reg, mnB, alB);
  __syncthreads(); RESC(alB);
  finishSM(pB0, pB1, alB, l_reg, pa0, pa1, pa2, pa3); SBAR();
  pv_d0(o, vb0 + (int)SHM_V, pa0, pa1, pa2, pa3);
  const int ooff = (wid * QBLK + 4 * hi) * LDO + r32;
#pragma unroll
  for (int r = 0; r < 16; ++r) {
#pragma unroll
    for (int d0 = 0; d0 < 4; ++d0) Ob[ooff + ((r & 3) + 8 * (r >> 2)) * LDO + d0 * 32] = (bf16)f2bf(o[d0][r]); }
  if (hi == 0) { const int mo = (wid * QBLK + r32) * 2; MLb[mo] = m_reg; MLb[mo + 1] = l_reg; }
  __syncthreads();
#undef SLOAD
#undef SWRITE
#undef SWAIT
#undef RESC
}
#undef KSWZ
#undef SBAR
}
#define XB_TMO      128
#define XB_XCNT(j)  (256  + 64 * (j))
#define XB_XSUB(j)  (1280 + 64 * (j))
#define XB_XGEN(j)  (2304 + 64 * (j))
#define XB_TOP      3328
#define XB_TOPGEN   3392
#define XCD_BAR_WORDS 3456
#define XB_SPIN_CAP (1u << 18)

__device__ __forceinline__ unsigned xb_ld(unsigned* p)              { return __hip_atomic_load(p, __ATOMIC_RELAXED, __HIP_MEMORY_SCOPE_AGENT); }
__device__ __forceinline__ unsigned xb_add(unsigned* p, unsigned v) { return __hip_atomic_fetch_add(p, v, __ATOMIC_RELAXED, __HIP_MEMORY_SCOPE_AGENT); }
__device__ __forceinline__ unsigned xb_xcc_id() { return (unsigned)__builtin_amdgcn_s_getreg((3 << 11) | 20) & 0xFu; }
#define XB_SPIN(cond, bar) do { unsigned _sp = 0; while (cond) { __builtin_amdgcn_s_sleep(1); \
    if ((++_sp & 255u) == 0u) { if (xb_ld(&(bar)[XB_TMO])) break; if (_sp > XB_SPIN_CAP) { atomicAdd(&(bar)[XB_TMO], 1u); break; } } } } while (0)

struct XcdBarrier {
    unsigned* bar; unsigned x;
    volatile LAS unsigned* st;
};

__device__ __forceinline__ XcdBarrier xcd_barrier_post(unsigned* bar, volatile LAS unsigned* st) {
    XcdBarrier b; b.bar = bar; b.x = xb_xcc_id(); b.st = st;
    if (threadIdx.x == 0) (void)xb_add(&bar[XB_XCNT(b.x)], 1u);
    return b;
}
__device__ __forceinline__ void xcd_barrier_complete(unsigned* bar, unsigned x, unsigned& nloc, unsigned& nx) {
    const unsigned G = gridDim.x * gridDim.y * gridDim.z;
    unsigned sum, cnt, mine, sp = 0u;
    for (;;) {
        sum = 0u; cnt = 0u; mine = 0u;
#pragma unroll
        for (unsigned j = 0; j < 16; ++j) { const unsigned c = xb_ld(&bar[XB_XCNT(j)]); sum += c; cnt += (c > 0u) ? 1u : 0u; mine = (j == x) ? c : mine; }
        if (sum == G) break;
        __builtin_amdgcn_s_sleep(1);
        if ((++sp & 255u) == 0u) { if (xb_ld(&bar[XB_TMO])) break; if (sp > XB_SPIN_CAP) { atomicAdd(&bar[XB_TMO], 1u); break; } }
    }
    nloc = mine > 0u ? mine : 1u; nx = cnt > 0u ? cnt : 1u;
}

__device__ __forceinline__ void xcd_barrier(const XcdBarrier& b) {
    asm volatile("s_waitcnt vmcnt(0)" ::: "memory");
    __syncthreads();
    if (threadIdx.x == 0) {
        unsigned* bar = b.bar;
        __builtin_amdgcn_s_waitcnt(0);
        unsigned nloc = b.st[0], nx = b.st[1];
        if (nloc == 0u) { xcd_barrier_complete(bar, b.x, nloc, nx); b.st[0] = nloc; b.st[1] = nx; }
        const unsigned old = xb_add(&bar[XB_XSUB(b.x)], 1u);
        const unsigned gen = old / nloc;
        if (old + 1u == (gen + 1u) * nloc) {
            __builtin_amdgcn_fence(__ATOMIC_RELEASE, "agent");
            asm volatile("s_waitcnt vmcnt(0)" ::: "memory");
            const unsigned og = xb_add(&bar[XB_TOP], 1u);
            const unsigned tg = og / nx;
            if (og + 1u == (tg + 1u) * nx) xb_add(&bar[XB_TOPGEN], 1u);
            else XB_SPIN(xb_ld(&bar[XB_TOPGEN]) == tg, bar);
            __builtin_amdgcn_fence(__ATOMIC_ACQUIRE, "agent");
            xb_add(&bar[XB_XGEN(b.x)], 1u);
            asm volatile("s_waitcnt vmcnt(0)" ::: "memory");
        } else {
            XB_SPIN(xb_ld(&bar[XB_XGEN(b.x)]) == gen, bar);
            __builtin_amdgcn_fence(__ATOMIC_ACQUIRE, "agent");
            asm volatile("s_waitcnt vmcnt(0)" ::: "memory");
        }
    }
    __syncthreads();
}

struct Params { const float* in[32]; float* out; unsigned char* ws; };

__device__ __forceinline__ void transpose_item(const float* W, int N, bf16* WT, int ldw, int koff, int rowoff, int upmode, LAS float* scr, int item, int lane) {
    const int nblk = N / 32, kb = item / nblk, nb = item % nblk, k0 = 64 * kb, n0 = 32 * nb;
#pragma unroll
    for (int i = 0; i < 32; ++i) { const int kk = 2 * i + (lane >> 5); scr[kk * 33 + (lane & 31)] = __builtin_nontemporal_load(&W[(size_t)(k0 + kk) * N + n0 + (lane & 31)]); }
    LDS_WAIT(); asm volatile("" ::: "memory");
    const int c = lane & 7;
#pragma unroll
    for (int j = 0; j < 4; ++j) { const int n = (lane >> 3) + 8 * j; const LAS float* s = scr + (8 * c) * 33 + n;
        v4u o; o.x = pk2(s[0 * 33], s[1 * 33]); o.y = pk2(s[2 * 33], s[3 * 33]); o.z = pk2(s[4 * 33], s[5 * 33]); o.w = pk2(s[6 * 33], s[7 * 33]);
        const int nn = n0 + n; int row;
        if (upmode) { const int isgt = nn >= DFF ? 1 : 0; const int jj = nn - isgt * DFF; row = (jj >> 7) * 256 + ((jj & 127) >> 4) * 32 + isgt * 16 + (jj & 15); }
        else row = rowoff + nn;
        __builtin_nontemporal_store(o, (GAS v4u*)(WT + (size_t)row * ldw + koff + k0 + 8 * c)); }
    LDS_WAIT(); asm volatile("" ::: "memory");
}

template <bool HAS_ADD>
__device__ __forceinline__ void row_phase(int vcu, int G, int tid, LAS float* lv, const float* xin_ctx, const float* xin_lat, float* X, const float* add, const float* ssq,
                                          const float* modg, const float* gpost, bool has_norm, const float* gnext, const float* modsc, const float* modsh, bf16* H) {
    const int lane = tid & 63, wave = __builtin_amdgcn_readfirstlane(tid >> 6), NGW = G * 8; int vcur = -1;
    for (int base = vcu * 8; base < MTOK; base += NGW) {
        const int row = base + wave, v = base < MCTX ? 0 : 1 + ((base - MCTX) >> 10);
        if (v != vcur) {
            __syncthreads();
            const int c4 = 4 * tid; const size_t vo = (size_t)v * N_ADA + c4;
            if constexpr (HAS_ADD) *(LAS f32x4*)(lv + c4) = *(const f32x4*)(modg + vo) * *(const f32x4*)(gpost + c4);
            if (has_norm) { *(LAS f32x4*)(lv + 2048 + c4) = *(const f32x4*)(gnext + c4) * (*(const f32x4*)(modsc + vo) + 1.0f); *(LAS f32x4*)(lv + 4096 + c4) = *(const f32x4*)(modsh + vo); }
            __syncthreads(); vcur = v;
        }
        const float* xr = row < MCTX ? xin_ctx + (size_t)row * DM : xin_lat + (size_t)(row - MCTX) * DM;
        f32x4 x[8];
#pragma unroll
        for (int j = 0; j < 8; ++j) x[j] = *(const f32x4*)(xr + 4 * lane + 256 * j);
        if constexpr (HAS_ADD) {
            const float* ar = add + (size_t)row * DM; f32x4 a[8];
#pragma unroll
            for (int j = 0; j < 8; ++j) a[j] = *(const f32x4*)(ar + 4 * lane + 256 * j);
            float sp = lane < 32 ? ssq[((size_t)(lane >> 2) * MTOK + row) * 4 + (lane & 3)] : 0.f;
            const float rs = __builtin_amdgcn_rsqf(wave_sum(sp) * (1.0f / DM) + EPS_);
#pragma unroll
            for (int j = 0; j < 8; ++j) x[j] = x[j] + *(const LAS f32x4*)(lv + 4 * lane + 256 * j) * (a[j] * rs);
        }
        float* xo = X + (size_t)row * DM;
#pragma unroll
        for (int j = 0; j < 8; ++j) *(f32x4*)(xo + 4 * lane + 256 * j) = x[j];
        if (has_norm) {
            float s2 = 0.f;
#pragma unroll
            for (int j = 0; j < 8; ++j) s2 += (x[j][0] * x[j][0] + x[j][1] * x[j][1]) + (x[j][2] * x[j][2] + x[j][3] * x[j][3]);
            const float r2 = __builtin_amdgcn_rsqf(wave_sum(s2) * (1.0f / DM) + EPS_);
            bf16* ho = H + (size_t)row * DM;
#pragma unroll
            for (int j = 0; j < 8; ++j) { const int col = 4 * lane + 256 * j;
                const f32x4 h = x[j] * r2 * *(const LAS f32x4*)(lv + 2048 + col) + *(const LAS f32x4*)(lv + 4096 + col); v2u w; w.x = pk2(h[0], h[1]); w.y = pk2(h[2], h[3]); *(v2u*)(ho + col) = w; }
        }
    }
    __syncthreads();
}

constexpr int PTAB_OFF = LDSCTL_OFF + 1024;
__device__ __forceinline__ const float* ldptr(LAS const unsigned long long* t, int i) {
    const unsigned long long v = t[i]; const unsigned lo = __builtin_amdgcn_readfirstlane((unsigned)v), hi = __builtin_amdgcn_readfirstlane((unsigned)(v >> 32));
    return (const float*)(GAS const float*)(((unsigned long long)hi << 32) | lo);
}
constexpr int I_IN = 32 * 192, I_GATE = 32 * 256, I_A = 8 * 64, I_B = 16 * 64, I_C = 8 * 64, I_D = 8 * 64, I_O = 32 * 64, I_UP = 32 * 352, I_DN = 88 * 64;
constexpr int I_LAYER = I_IN + I_GATE + I_A + I_B + I_C + I_D + I_O + I_UP + I_DN;
#define CONVERT_ITEM(LL, ITEM) do { const int l_ = (LL); int r = (ITEM); \
    const float* W; int N; bf16* WT; int ldw, koff = 0, rowoff = 0, up = 0; \
    if (r < I_IN) { W = IN(12) + (size_t)l_ * DM * DIN_; N = DIN_; WT = (bf16*)(ws + WS_WIG + l_ * SZ_WIG); ldw = DM; } \
    else if ((r -= I_IN) < I_GATE) { W = IN(27) + (size_t)l_ * DM * NGATE; N = NGATE; WT = (bf16*)(ws + WS_WIG + l_ * SZ_WIG); ldw = DM; rowoff = DIN_; } \
    else if ((r -= I_GATE) < I_A) { W = IN(17) + (size_t)l_ * 512 * DM; N = DM; WT = (bf16*)(ws + WS_WBR + l_ * SZ_WBR); ldw = KBR; koff = 0; } \
    else if ((r -= I_A) < I_B) { W = IN(23) + (size_t)l_ * 1024 * DM; N = DM; WT = (bf16*)(ws + WS_WBR + l_ * SZ_WBR); ldw = KBR; koff = 512; } \
    else if ((r -= I_B) < I_C) { W = IN(25) + (size_t)l_ * 512 * DM; N = DM; WT = (bf16*)(ws + WS_WBR + l_ * SZ_WBR); ldw = KBR; koff = 1536; } \
    else if ((r -= I_C) < I_D) { W = IN(26) + (size_t)l_ * 512 * DM; N = DM; WT = (bf16*)(ws + WS_WBR + l_ * SZ_WBR); ldw = KBR; koff = 2048; } \
    else if ((r -= I_D) < I_O) { W = IN(29) + (size_t)l_ * DM * DM; N = DM; WT = (bf16*)(ws + WS_WO + l_ * SZ_WO); ldw = DM; } \
    else if ((r -= I_O) < I_UP) { W = IN(30) + (size_t)l_ * DM * NUP; N = NUP; WT = (bf16*)(ws + WS_WUP + l_ * SZ_WUP); ldw = DM; up = 1; } \
    else { r -= I_UP; W = IN(31) + (size_t)l_ * DFF * DM; N = DM; WT = (bf16*)(ws + WS_WDN + l_ * SZ_WDN); ldw = DFF; } \
    transpose_item(W, N, WT, ldw, koff, rowoff, up, scr, r, lane); } while (0)
#define CONVERT_SLOT(NUNITS, B, E) do { if (l + 1 < nlayers) { const int rem_ = (NUNITS) % G, first_ = rem_; \
    if (bx >= first_) { LAS float* scr = (LAS float*)(lds + wave * 16384); const int nw_ = (G - first_) * 8; \
        for (int it = (B) + (bx - first_) * 8 + wave; it < (E); it += nw_) { CONVERT_ITEM(l + 1, it); } } } } while (0)
__global__ void __launch_bounds__(512, 2) mk_fwd(Params p) {
    extern __shared__ __attribute__((aligned(16))) unsigned char lds_raw[];
    LAS unsigned char* lds = (LAS unsigned char*)lds_raw;
    volatile LAS unsigned* MISC = (volatile LAS unsigned*)(lds + MISC_OFF);
    const int wave_s = __builtin_amdgcn_readfirstlane(threadIdx.x >> 6);
    for (int u = threadIdx.x; u < (LDS_BYTES - LDSCTL_OFF) / 4; u += 512) ((LAS unsigned*)(lds + LDSCTL_OFF))[u] = 0u;
    __syncthreads();
    if (threadIdx.x == 0) { LAS unsigned long long* t = (LAS unsigned long long*)(lds + PTAB_OFF);
#pragma unroll
        for (int i = 0; i < 32; ++i) t[i] = (unsigned long long)p.in[i];
        t[32] = (unsigned long long)p.out; t[33] = (unsigned long long)p.ws; }
    __syncthreads();
    (void)xcd_barrier_post((unsigned*)(p.ws + WS_CTL) + CW_BAR, MISC + 8);
#ifndef MK_STOP
#define MK_STOP 0
#endif
#ifndef MI_UP
#define MI_UP 4
#endif
#ifndef MI_N
#define MI_N 3
#endif
#ifndef MK_TPROBE
#define MK_TPROBE (-1)
#endif
#ifndef MK_TAMP
#define MK_TAMP 4
#endif
#if MK_TPROBE >= 0
#define TSTART(id) do { if ((id) == MK_TPROBE && blockIdx.x == 0 && wave_s == 0) MISC[18] = (unsigned)__builtin_amdgcn_s_memrealtime(); } while (0)
#define TSTOP(id) do { if ((id) == MK_TPROBE && blockIdx.x == 0 && wave_s == 0) MISC[16] = MISC[16] + ((unsigned)__builtin_amdgcn_s_memrealtime() - MISC[18]); } while (0)
#else
#define TSTART(id) do {} while (0)
#define TSTOP(id) do {} while (0)
#endif
#define RUN(k) (MK_STOP == 0 || (MK_STOP >= (k) && MK_STOP < 11) || (MK_STOP == 11 && (k) == 1))
#define GRID_BAR() do { unsigned pto2_ = PTAB_OFF; asm volatile("" : "+s"(pto2_)); XcdBarrier b_; \
    b_.bar = (unsigned*)((unsigned char*)ldptr((LAS const unsigned long long*)(lds + pto2_), 33) + WS_CTL) + CW_BAR; b_.x = xb_xcc_id(); b_.st = MISC + 8; xcd_barrier(b_); } while (0)
#define PH_BEGIN() int tid; unsigned pto_ = PTAB_OFF; int G = gridDim.x, bx = blockIdx.x; \
    asm volatile("v_mbcnt_lo_u32_b32 %0, -1, 0\n\tv_mbcnt_hi_u32_b32 %0, -1, %0" : "=v"(tid), "+s"(pto_), "+s"(G), "+s"(bx)); tid += wave_s * 64; \
    const int vcu = (G % 8 == 0) ? (bx % 8) * (G / 8) + bx / 8 : bx, NGW = G * 8, NGT = G * 512; (void)NGW; (void)NGT; \
    LAS const unsigned long long* const pt_ = (LAS const unsigned long long*)(lds + pto_); unsigned char* const ws = (unsigned char*)ldptr(pt_, 33); float* const outp = (float*)ldptr(pt_, 32); (void)outp; \
    const int lane = tid & 63, wave = __builtin_amdgcn_readfirstlane(tid >> 6), gw = vcu * 8 + wave, gt = vcu * 512 + tid; (void)lane; (void)gw; (void)gt
#define MOD ((float*)(ws + WS_MOD))
#define PARTMOD ((float*)(ws + WS_PARTMOD))
#define LAM ((float*)(ws + WS_LAM))
#define ROPE ((float*)(ws + WS_ROPE))
#define TWC ((bf16*)(ws + WS_TWC))
#define TW256 ((bf16*)(ws + WS_TW256))
#define TW1024 ((bf16*)(ws + WS_TW1024))
#define Hb ((bf16*)(ws + WS_H))
#define PROJ ((bf16*)(ws + WS_PROJ))
#define GATES ((unsigned char*)(ws + WS_GATES))
#define KCTX ((bf16*)(ws + WS_KCTX))
#define VCTX ((bf16*)(ws + WS_VCTX))
#define AO ((bf16*)(ws + WS_AO))
#define ML ((float*)(ws + WS_ML))
#define BR ((bf16*)(ws + WS_BR))
#define PQC ((bf16*)(ws + WS_PQC))
#define PQL ((bf16*)(ws + WS_PQL))
#define PART ((unsigned*)(ws + WS_PART))
#define MERGED ((bf16*)(ws + WS_MERGED))
#define MIX ((float*)(ws + WS_MIX))
#define SSQ ((float*)(ws + WS_SSQ))
#define FACT ((bf16*)(ws + WS_FACT))
#define X (outp + OUT_Y)
#define IN(i) ldptr(pt_, i)
#define MODl (MOD + (size_t)l * 3 * N_ADA)
#define KLATl ((bf16*)(ws + WS_KLAT + l * SZ_KLAT))
#define VLATl ((bf16*)(ws + WS_VLAT + l * SZ_KLAT))

    TSTART(0);
    {
        PH_BEGIN();
        LAS float* scr = (LAS float*)(lds + wave * 16384);
        for (int it = gw; it < NL * I_LAYER; it += NGW) { CONVERT_ITEM(it / I_LAYER, it % I_LAYER); }
        for (int it = gw; it < NL * 32 * 48; it += NGW) {
            const int l = it / 1536, r = it % 1536, ks = r / 48, nc = r % 48, k0 = ks * 64, n = nc * 256 + 4 * lane;
            float c0 = IN(5)[k0 + lane], c1 = IN(4)[k0 + lane], c2 = IN(4)[DM + k0 + lane];
            c0 = c0 / (1.0f + __expf(-c0)); c1 = c1 / (1.0f + __expf(-c1)); c2 = c2 / (1.0f + __expf(-c2));
            const float* wp = IN(6) + ((size_t)l * DM + k0) * N_ADA + n;
            f32x4 a0 = {0.f, 0.f, 0.f, 0.f}, a1 = a0, a2 = a0;
#pragma unroll 8
            for (int k = 0; k < 64; ++k) { const f32x4 w = *(const f32x4*)(wp + (size_t)k * N_ADA);
                const float s0 = __shfl(c0, k), s1 = __shfl(c1, k), s2 = __shfl(c2, k); a0 += w * s0; a1 += w * s1; a2 += w * s2; }
            float* po = PARTMOD + ((size_t)(l * 32 + ks) * 3) * N_ADA + n;
            *(f32x4*)(po) = a0; *(f32x4*)(po + N_ADA) = a1; *(f32x4*)(po + 2 * N_ADA) = a2;
        }
        for (int i = gt; i < 2 * 524288; i += NGT) {
            const int t = i >= 524288 ? 1 : 0, j = i - t * 524288; const size_t e = (size_t)j * 8;
            const int b = (int)(e >> 21), l = (int)(e >> 19) & 3, tt = (int)(e >> 10) & 511, c = (int)e & 1023;
            const float* src = (t ? IN(3) : IN(2)) + e; const f32x4 v0 = *(const f32x4*)src, v1 = *(const f32x4*)(src + 4);
            v4u o; o.x = pk2(v0[0], v0[1]); o.y = pk2(v0[2], v0[3]); o.z = pk2(v1[0], v1[1]); o.w = pk2(v1[2], v1[3]);
            bf16* dst = (bf16*)(ws + (t ? WS_VLAT : WS_KLAT) + l * SZ_KLAT) + ((size_t)(b * 1536 + tt)) * 1024 + c;
            *(v4u*)dst = o;
        }
        for (int i = gt; i < 512 * 256; i += NGT) { const int mr = i >> 8, kk = i & 255, gg = mr >> 8, pq = (mr >> 7) & 1, j = mr & 127, gg2 = kk >> 7, c = kk & 127;
            const float ang = (float)((j * c) & 127) * (2.0f / 128.0f); float v = pq ? sinpif(ang) : cospif(ang); v *= 0.08838834764831845f;
            TWC[i] = (bf16)f2bf(gg == gg2 ? v : 0.f); }
        for (int i = gt; i < 256 * 512; i += NGT) { const int k = i >> 9, kk = i & 511, pq = kk >> 8, t = kk & 255; const float ang = (float)((k * t) & 255) * (2.0f / 256.0f);
            const float v = (pq ? -sinpif(ang) : cospif(ang)) * 0.0625f; TW256[i] = (bf16)f2bf(v); }
        for (int i = gt; i < 1024 * 2048; i += NGT) { const int k = i >> 11, kk = i & 2047, pq = kk >> 10, t = kk & 1023; const float ang = (float)((k * t) & 1023) * (2.0f / 1024.0f);
            const float v = (pq ? -sinpif(ang) : cospif(ang)) * 0.03125f; TW1024[i] = (bf16)f2bf(v); }
        for (int i = gt; i < 64 * 32; i += NGT) { const int pos = i >> 5, fi = i & 31; const float inv = powf(10000.0f, -(float)(2 * fi) / 64.0f); const float a = (float)pos * inv;
            ROPE[2 * i] = cosf(a); ROPE[2 * i + 1] = sinf(a); }
        if (gt < NL) { const int l = gt; float s1 = 0.f, s2 = 0.f;
            for (int k = 0; k < 128; ++k) { s1 += IN(18)[l * 128 + k] * IN(19)[l * 128 + k]; s2 += IN(20)[l * 128 + k] * IN(21)[l * 128 + k]; }
            const float li = 0.8f - 0.6f * expf(-0.3f * (float)l); LAM[2 * l] = expf(s1) - expf(s2) + li; LAM[2 * l + 1] = 1.0f - li; }
    }
    GRID_BAR();
    { PH_BEGIN();
    for (int i = gt; i < NL * 3 * N_ADA; i += NGT) { const int l = i / (3 * N_ADA), r = i % (3 * N_ADA), v = r / N_ADA, n = r % N_ADA; float s = IN(7)[l * N_ADA + n];
        for (int ks = 0; ks < 32; ++ks) s += PARTMOD[((size_t)(l * 32 + ks) * 3 + v) * N_ADA + n];
        MOD[i] = s; } }
    GRID_BAR();
    { PH_BEGIN(); row_phase<false>(vcu, G, tid, (LAS float*)lds, IN(0), IN(1), X, nullptr, nullptr, nullptr, nullptr, true, IN(8), MOD + 2048, MOD, Hb); }
    GRID_BAR();
    TSTOP(0);

    int nlayers = MK_LAYERS; asm volatile("" : "+s"(nlayers));
    for (int l = 0; l < nlayers; ++l) {
        TSTART(1);
        if (RUN(1)) {
            PH_BEGIN();
            const int nfull1 = (24 * 56 / G) * G;
            pg8::SchedMain S{24, 56, G, bx, nfull1, (const char*)Hb, (const char*)(ws + WS_WIG + l * SZ_WIG), (size_t)DM * 2, (size_t)DM * 2, pg8::G1_PN};
            pg8::EpiG1<4> E{PROJ, GATES, KCTX, VCTX, KLATl, VLATl, outp + OUT_NK + (size_t)l * 256 * 1024, outp + OUT_NV + (size_t)l * 256 * 1024, IN(28) + (size_t)l * NGATE};
            pg8::gemm_stream<pg8::EpiG1<4>, pg8::SchedMain>(lds, tid, DM, DM, S, E);
            pg8::SchedLeft S2{24, 56, G, bx, nfull1, (const char*)Hb, (const char*)(ws + WS_WIG + l * SZ_WIG), (size_t)DM * 2, (size_t)DM * 2, pg8::G1_PN};
            pg8::EpiG1<2> E2{PROJ, GATES, KCTX, VCTX, KLATl, VLATl, outp + OUT_NK + (size_t)l * 256 * 1024, outp + OUT_NV + (size_t)l * 256 * 1024, IN(28) + (size_t)l * NGATE};
            pg8::gemm_stream<pg8::EpiG1<2>, pg8::SchedLeft, 2>(lds, tid, DM, DM, S2, E2);
        }
        GRID_BAR();
        TSTOP(1);
        TSTART(2);
        if (RUN(2)) {
            { PH_BEGIN();
            for (int i = gt; i < 2048 * 128; i += NGT) {
                const int tok = i >> 7, r = i & 127, tensor = r >> 6, h = (r >> 4) & 3, m = (r >> 3) & 1, half = (r >> 2) & 1, j8 = r & 3;
                const int b = tok >> 10, t = tok & 1023, pos = half ? (t & 63) : (t >> 6);
                bf16* q = tensor == 0 ? PROJ + (size_t)(MCTX + tok) * DIN_ + 1024 : KLATl + (size_t)(b * 1536 + 512 + t) * 1024;
                q += h * 256 + m * 128 + half * 64 + j8 * 8;
                const v4u x1 = *(const v4u*)q, x2 = *(const v4u*)(q + 32);
                const float* cs = ROPE + (size_t)(pos * 32 + j8 * 8) * 2;
                const f32x4 t0 = *(const f32x4*)cs, t1 = *(const f32x4*)(cs + 4), t2 = *(const f32x4*)(cs + 8), t3 = *(const f32x4*)(cs + 12);
                const float co[8] = {t0[0], t0[2], t1[0], t1[2], t2[0], t2[2], t3[0], t3[2]}, si[8] = {t0[1], t0[3], t1[1], t1[3], t2[1], t2[3], t3[1], t3[3]};
                const unsigned xa[4] = {x1.x, x1.y, x1.z, x1.w}, xb[4] = {x2.x, x2.y, x2.z, x2.w}; unsigned oa[4], ob[4];
#pragma unroll
                for (int e = 0; e < 4; ++e) { const float a0 = bf_lo(xa[e]), a1 = bf_hi(xa[e]), b0 = bf_lo(xb[e]), b1 = bf_hi(xb[e]);
                    oa[e] = pk2(a0 * co[2 * e] - b0 * si[2 * e], a1 * co[2 * e + 1] - b1 * si[2 * e + 1]);
                    ob[e] = pk2(b0 * co[2 * e] + a0 * si[2 * e], b1 * co[2 * e + 1] + a1 * si[2 * e + 1]); }
                *(v4u*)q = (v4u){oa[0], oa[1], oa[2], oa[3]}; *(v4u*)(q + 32) = (v4u){ob[0], ob[1], ob[2], ob[3]};
            }
            }
            {
                PH_BEGIN();
                const float* wc3 = IN(24) + (size_t)l * 3 * 512;
                for (int i = gt; i < MTOK * 64; i += NGT) {
                    const int row = i >> 6, c8 = (i & 63) * 8; int s0, T; if (row < MCTX) { s0 = row & ~255; T = 256; } else { s0 = MCTX + ((row - MCTX) & ~1023); T = 1024; }
                    float acc8[8] = {0.f, 0.f, 0.f, 0.f, 0.f, 0.f, 0.f, 0.f};
#pragma unroll
                    for (int dk = 0; dk < 3; ++dk) { const int g = row + dk - 1;
                        if (g >= s0 && g < s0 + T) { const bf16* pr = PROJ + (size_t)g * DIN_ + c8; const v4u sc = *(const v4u*)(pr + 4608), sx = *(const v4u*)(pr + 5120);
                            const f32x4 w0 = *(const f32x4*)(wc3 + dk * 512 + c8), w1 = *(const f32x4*)(wc3 + dk * 512 + c8 + 4);
                            const unsigned sa[4] = {sc.x, sc.y, sc.z, sc.w}, sb[4] = {sx.x, sx.y, sx.z, sx.w}; const float wv[8] = {w0[0], w0[1], w0[2], w0[3], w1[0], w1[1], w1[2], w1[3]};
#pragma unroll
                            for (int e = 0; e < 4; ++e) { acc8[2 * e] += wv[2 * e] * (bf_lo(sa[e]) * bf_lo(sb[e])); acc8[2 * e + 1] += wv[2 * e + 1] * (bf_hi(sa[e]) * bf_hi(sb[e])); } } }
                    const v4u sbv = *(const v4u*)(PROJ + (size_t)row * DIN_ + 4096 + c8); const unsigned sbb[4] = {sbv.x, sbv.y, sbv.z, sbv.w}; unsigned o[4];
#pragma unroll
                    for (int e = 0; e < 4; ++e) o[e] = pk2(bf_lo(sbb[e]) * acc8[2 * e], bf_hi(sbb[e]) * acc8[2 * e + 1]);
                    *(v4u*)(BR + (size_t)row * KBR + 1536 + c8) = (v4u){o[0], o[1], o[2], o[3]};
                }
            }
            {
                PH_BEGIN();
                const int c = tid; float w[31];
#pragma unroll
                for (int k = 0; k < 31; ++k) w[k] = IN(13)[((size_t)l * 31 + k) * 512 + c];
                const float cb = IN(14)[l * 512 + c];
                LAS float* so = (LAS float*)lds;
                for (int u = vcu; u < MTOK / 16; u += G) {
                    const int row0 = u * 16; int s0, T; if (row0 < MCTX) { s0 = row0 & ~255; T = 256; } else { s0 = MCTX + ((row0 - MCTX) & ~1023); T = 1024; }
                    float in[46];
#pragma unroll
                    for (int r = 0; r < 46; ++r) { const int g = row0 - 15 + r; float v = 0.f;
                        if (g >= s0 && g < s0 + T) { const bf16* pr = PROJ + (size_t)g * DIN_ + c; v = bf2f(pr[0]) * sigmoid_f(bf2f(pr[512])); }
                        in[r] = v; }
#pragma unroll
                    for (int t = 0; t < 16; ++t) { float o = cb;
#pragma unroll
                        for (int k = 0; k < 31; ++k) o += w[k] * in[t + k];
                        so[t * 512 + c] = o; }
                    __syncthreads();
#pragma unroll
                    for (int q = 0; q < 2; ++q) { const int t = 2 * wave + q; float v[8]; float s = 0.f;
#pragma unroll
                        for (int j = 0; j < 8; ++j) { v[j] = so[t * 512 + lane + 64 * j]; s += v[j]; }
                        const float mean = wave_sum(s) * (1.0f / 512.0f); float s2 = 0.f;
#pragma unroll
                        for (int j = 0; j < 8; ++j) { v[j] -= mean; s2 += v[j] * v[j]; }
                        const float rstd = __builtin_amdgcn_rsqf(wave_sum(s2) * (1.0f / 512.0f) + EPS_);
#pragma unroll
                        for (int j = 0; j < 8; ++j) { const int cc = lane + 64 * j; float y = v[j] * rstd * IN(15)[l * 512 + cc] + IN(16)[l * 512 + cc]; y = y * sigmoid_f(y);
                            BR[(size_t)(row0 + t) * KBR + cc] = (bf16)f2bf(y); } }
                    __syncthreads();
                }
            }
            {
                PH_BEGIN();
                int nt4 = 4; asm volatile("" : "+s"(nt4));
                const int nconv2 = (MTOK / 16) - G;
                const bool place = nconv2 >= 0 && G - nconv2 >= 96;
                pg8::SchedF1 S{place ? 96 : G, place ? (vcu >= nconv2 ? vcu - nconv2 : 96) : bx, nt4, (const char*)TWC, (const char*)PROJ};
                pg8::EpiF1 E{PQC, PQL};
                pg8::gemm_stream<pg8::EpiF1, pg8::SchedF1>(lds, tid, 256, DIN_, S, E);
            }
        }
        GRID_BAR();
        TSTOP(2);
        TSTART(3);
        if (RUN(3)) {
            { PH_BEGIN();
            for (int ui = vcu; ui < 512; ui += G) {
                const bf16 *Q, *K, *V; bf16* Ob; float* MLb; int seq;
                if (ui < 256) { const int u = ui, split = u & 1, qb = (u >> 1) & 3, vh = (u >> 3) & 1, m = (u >> 4) & 1, h = (u >> 5) & 3, b = u >> 7;
                    const int tok0 = MCTX + b * 1024 + qb * 256, slot = (h * 2 + m) * 2 + vh;
                    Q = PROJ + (size_t)tok0 * DIN_ + 1024 + h * 256 + m * 128;
                    K = KLATl + (size_t)(b * 1536 + split * 768) * 1024 + h * 256 + m * 128; V = VLATl + (size_t)(b * 1536 + split * 768) * 1024 + h * 256 + vh * 128;
                    Ob = AO + ((size_t)split * MTOK + tok0) * 2048 + slot * 128; MLb = ML + (((size_t)split * 16 + slot) * MTOK + tok0) * 2; seq = 768; }
                else { const int u = ui - 256, vh = u & 1, m = (u >> 1) & 1, h = (u >> 2) & 3, s = u >> 4; const int tok0 = s * 256, slot = (h * 2 + m) * 2 + vh;
                    Q = PROJ + (size_t)tok0 * DIN_ + 1024 + h * 256 + m * 128;
                    K = KCTX + (size_t)tok0 * 1024 + h * 256 + m * 128; V = VCTX + (size_t)tok0 * 1024 + h * 256 + vh * 128;
                    Ob = AO + (size_t)tok0 * 2048 + slot * 128; MLb = ML + ((size_t)slot * MTOK + tok0) * 2; seq = 256; }
                att::attn_unit(Q, K, V, Ob, MLb, seq, (LAS char*)lds, tid);
            } }
            {
                PH_BEGIN();
                pg8::SchedF2L S{G, bx, (const char*)TW1024, (const char*)PQL};
                pg8::EpiF2P E{(float*)(ws + WS_FP)};
                pg8::gemm_stream<pg8::EpiF2P, pg8::SchedF2L>(lds, tid, 2048, 2048, S, E);
            }
            {
                PH_BEGIN();
                pg8::SchedF2C S{G, bx, (const char*)TW256, (const char*)PQC};
                pg8::EpiBf16 E{BR, KBR, 2048};
                pg8::gemm_stream<pg8::EpiBf16, pg8::SchedF2C>(lds, tid, 512, 512, S, E);
            }
        }
        GRID_BAR();
        TSTOP(3);
        TSTART(4);
        if (RUN(4)) {
            PH_BEGIN();
            {
                const float* fp = (const float*)(ws + WS_FP);
                for (int t = gw; t < 2048; t += NGW) { const float* r0 = fp + (size_t)t * 512 + 8 * lane; f32x4 a0 = *(const f32x4*)r0, a1 = *(const f32x4*)(r0 + 4);
#pragma unroll
                    for (int ks = 1; ks < 4; ++ks) { a0 += *(const f32x4*)(r0 + (size_t)ks * 2048 * 512); a1 += *(const f32x4*)(r0 + (size_t)ks * 2048 * 512 + 4); }
                    v4u w; w.x = pk2(a0[0], a0[1]); w.y = pk2(a0[2], a0[3]); w.z = pk2(a1[0], a1[1]); w.w = pk2(a1[2], a1[3]);
                    *(v4u*)(BR + (size_t)(MCTX + t) * KBR + 2048 + 8 * lane) = w; }
            }
            const float lam = LAM[2 * l], oml = LAM[2 * l + 1]; constexpr float C = att::SCALE * 1.4426950408889634f;
            for (int tok = gw; tok < MTOK; tok += NGW) {
                const int vh = lane >> 5, d4 = (lane & 31) * 4; const bool two = tok >= MCTX;
                v2u o0w[4][2], o1w[4][2]; float m0[4][2], l0[4][2], m1[4][2], l1[4][2];
#pragma unroll
                for (int h = 0; h < 4; ++h)
#pragma unroll
                    for (int m = 0; m < 2; ++m) { const int slot = (h * 2 + m) * 2 + vh;
                        o0w[h][m] = *(const v2u*)(AO + (size_t)tok * 2048 + slot * 128 + d4); m0[h][m] = ML[((size_t)slot * MTOK + tok) * 2]; l0[h][m] = ML[((size_t)slot * MTOK + tok) * 2 + 1];
                        if (two) { o1w[h][m] = *(const v2u*)(AO + ((size_t)MTOK + tok) * 2048 + slot * 128 + d4); m1[h][m] = ML[((size_t)(16 + slot) * MTOK + tok) * 2]; l1[h][m] = ML[((size_t)(16 + slot) * MTOK + tok) * 2 + 1]; }
                        else { o1w[h][m] = (v2u){0u, 0u}; m1[h][m] = 0.f; l1[h][m] = 0.f; } }
                f32x4 gq[4];
#pragma unroll
                for (int h = 0; h < 4; ++h) gq[h] = *(const f32x4*)(IN(22) + l * 256 + vh * 128 + d4);
#pragma unroll
                for (int h = 0; h < 4; ++h) {
                    f32x4 val[2];
#pragma unroll
                    for (int m = 0; m < 2; ++m) { const v2u a0 = o0w[h][m]; const f32x4 o0 = {bf_lo(a0.x), bf_hi(a0.x), bf_lo(a0.y), bf_hi(a0.y)};
                        if (two) { const v2u a1 = o1w[h][m]; const f32x4 o1 = {bf_lo(a1.x), bf_hi(a1.x), bf_lo(a1.y), bf_hi(a1.y)};
                            const float mm = fmaxf(m0[h][m], m1[h][m]), e0 = __builtin_amdgcn_exp2f((m0[h][m] - mm) * C), e1 = __builtin_amdgcn_exp2f((m1[h][m] - mm) * C);
                            val[m] = (o0 * e0 + o1 * e1) * (1.0f / (l0[h][m] * e0 + l1[h][m] * e1)); }
                        else val[m] = o0 * (1.0f / l0[h][m]); }
                    const f32x4 o = val[0] - val[1] * lam;
                    const float ss = wave_sum((o[0] * o[0] + o[1] * o[1]) + (o[2] * o[2] + o[3] * o[3]));
                    const float rs = __builtin_amdgcn_rsqf(ss * (1.0f / 256.0f) + EPS_) * oml;
                    const f32x4 r = o * rs * gq[h];
                    v2u w; w.x = pk2(r[0], r[1]); w.y = pk2(r[2], r[3]); *(v2u*)(BR + (size_t)tok * KBR + 512 + h * 256 + vh * 128 + d4) = w;
                }
            }
        }
        GRID_BAR();
        TSTOP(4);
        TSTART(5);
        if (RUN(5)) {
            PH_BEGIN();
            pg8::SchedG2<MI_N> S{G, bx, (const char*)BR, (const char*)(ws + WS_WBR + l * SZ_WBR)};
            pg8::EpiG2<MI_N> E{GATES, PART, MERGED};
            pg8::gemm_stream<pg8::EpiG2<MI_N>, pg8::SchedG2<MI_N>, MI_N>(lds, tid, KBR, KBR, S, E);
        }
        GRID_BAR();
        TSTOP(5);
        TSTART(6);
        if (RUN(6)) {
            PH_BEGIN();
            pg8::TileSched S{MTOK / (64 * MI_N), 8, G, bx, 32, (const char*)MERGED, (const char*)(ws + WS_WO + l * SZ_WO), (size_t)(64 * MI_N) * DM * 2, (size_t)256 * DM * 2};
            pg8::EpiSsq<MI_N> E{MIX, SSQ};
            pg8::gemm_stream<pg8::EpiSsq<MI_N>, pg8::TileSched, MI_N>(lds, tid, DM, DM, S, E);
        }
        GRID_BAR();
        TSTOP(6);
        TSTART(7);
        if (RUN(7)) { PH_BEGIN(); row_phase<true>(vcu, G, tid, (LAS float*)lds, X, X + (size_t)MCTX * DM, X, MIX, SSQ, MODl + 4096, IN(9) + l * DM, true, IN(10) + l * DM, MODl + 8192, MODl + 6144, Hb); }
        GRID_BAR();
        TSTOP(7);
        TSTART(8);
        if (RUN(8)) {
            PH_BEGIN();
            const int nfull4 = (24 * 44 / G) * G;
            pg8::SchedMain S{24, 44, G, bx, nfull4, (const char*)Hb, (const char*)(ws + WS_WUP + l * SZ_WUP), (size_t)DM * 2, (size_t)DM * 2, nullptr};
            pg8::EpiSwiGLU<4> E{FACT};
            pg8::gemm_stream<pg8::EpiSwiGLU<4>, pg8::SchedMain>(lds, tid, DM, DM, S, E);
            pg8::SchedLeft S2{24, 44, G, bx, nfull4, (const char*)Hb, (const char*)(ws + WS_WUP + l * SZ_WUP), (size_t)DM * 2, (size_t)DM * 2, nullptr};
            pg8::EpiSwiGLU<2> E2{FACT};
            pg8::gemm_stream<pg8::EpiSwiGLU<2>, pg8::SchedLeft, 2>(lds, tid, DM, DM, S2, E2);
        }
        GRID_BAR();
        TSTOP(8);
        TSTART(9);
        if (RUN(9)) {
            PH_BEGIN();
            pg8::TileSched S{MTOK / (64 * MI_N), 8, G, bx, 88, (const char*)FACT, (const char*)(ws + WS_WDN + l * SZ_WDN), (size_t)(64 * MI_N) * DFF * 2, (size_t)256 * DFF * 2};
            pg8::EpiSsq<MI_N> E{MIX, SSQ};
            pg8::gemm_stream<pg8::EpiSsq<MI_N>, pg8::TileSched, MI_N>(lds, tid, DFF, DFF, S, E);
        }
        GRID_BAR();
        TSTOP(9);
        TSTART(10);
        if (RUN(10)) {
            PH_BEGIN();
            const bool more = (l + 1 < NL); const int ln = more ? l + 1 : l;
            row_phase<true>(vcu, G, tid, (LAS float*)lds, X, X + (size_t)MCTX * DM, X, MIX, SSQ, MODl + 10240, IN(11) + l * DM, more, IN(8) + ln * DM, MOD + (size_t)ln * 3 * N_ADA + 2048, MOD + (size_t)ln * 3 * N_ADA, Hb);
        }
        if (l + 1 < nlayers) GRID_BAR();
        TSTOP(10);
    }
#if MK_TPROBE >= 0
    if (blockIdx.x == 0 && wave_s == 0) { asm volatile("s_waitcnt vmcnt(0)" ::: "memory"); const unsigned long long t0 = __builtin_amdgcn_s_memrealtime(), d = (unsigned long long)MISC[16] * MK_TAMP;
        while (__builtin_amdgcn_s_memrealtime() - t0 < d) __builtin_amdgcn_s_sleep(8); }
#endif
#if MK_STOP
    { GRID_BAR(); PH_BEGIN();
      for (size_t i = gt; i < (size_t)MTOK * DM; i += NGT) { const size_t row = i >> 11; const int col = (int)(i & 2047); float v = 0.f;
        if (MK_STOP == 2) v = col < 512 ? bf2f(BR[row * KBR + col]) : (col < 1024 ? bf2f(BR[row * KBR + 1536 + col - 512]) : bf2f(PROJ[row * DIN_ + col]));
        else if (MK_STOP == 3) v = bf2f(AO[row * 2048 + col]);
        else if (MK_STOP == 4) v = col < 1024 ? bf2f(BR[row * KBR + 512 + col]) : (col < 1536 ? bf2f(BR[row * KBR + 2048 + col - 1024]) : 0.f);
        else if (MK_STOP == 5) v = bf2f(MERGED[i]);
        else if (MK_STOP == 6 || MK_STOP == 9) v = MIX[i];
        else if (MK_STOP == 8) v = bf2f(FACT[row * DFF + col]);
        else if (MK_STOP == 11) v = (float)GATES[row * NGATE + col];
        else continue;
        X[i] = v; } }
#endif
#if MK_LAYERS < 4
    PH_BEGIN();
    for (size_t i = gt; i < (size_t)16 * 4 * 256 * 1024; i += NGT) { const int l = (int)((i >> 18) & 3); if (l >= MK_LAYERS) { outp[OUT_NK + i] = 0.f; outp[OUT_NV + i] = 0.f; } }
#endif
#undef GRID_BAR
}

extern "C" void kernel_launch(void* const* d_in, const int* in_sizes, int n_in, void* d_out, int out_size, void* d_ws, size_t ws_size, hipStream_t stream) {
    static int grid = 0;
    if (grid == 0) {
        if (n_in != 32 || (size_t)out_size != OUT_TOTAL || ws_size < WS_END) { fprintf(stderr, "kernel_launch: built for 32 inputs, %zu outputs, >= %zu bytes of workspace; got n_in %d, out %d, ws %zu; nothing launched\n", OUT_TOTAL, (size_t)WS_END, n_in, out_size, ws_size); grid = -1; return; }
        int dev = 0, cus = 0, per_cu = 0;
        if (hipGetDevice(&dev) != hipSuccess || hipDeviceGetAttribute(&cus, hipDeviceAttributeMultiprocessorCount, dev) != hipSuccess) { fprintf(stderr, "kernel_launch: device query failed\n"); grid = -1; return; }
        if (hipFuncSetAttribute((const void*)mk_fwd, hipFuncAttributeMaxDynamicSharedMemorySize, LDS_BYTES) != hipSuccess) { fprintf(stderr, "kernel_launch: hipFuncSetAttribute failed\n"); grid = -1; return; }
        if (hipOccupancyMaxActiveBlocksPerMultiprocessor(&per_cu, (const void*)mk_fwd, 512, LDS_BYTES) != hipSuccess || per_cu < 1) { fprintf(stderr, "kernel_launch: occupancy query reports %d workgroups per CU\n", per_cu); }
        (void)hipGetLastError();
        grid = cus;
    }
    if (grid < 0) return;
#ifdef MK_ZERO_WS
    (void)hipMemsetAsync((char*)d_ws, 0, WS_END, stream);
#endif
    if (hipMemsetAsync((char*)d_ws + WS_CTL, 0, CTL_ZERO_BYTES, stream) != hipSuccess) { fprintf(stderr, "kernel_launch: hipMemsetAsync failed\n"); return; }
    Params p{};
    for (int i = 0; i < 32; ++i) p.in[i] = (const float*)d_in[i];
    p.out = (float*)d_out; p.ws = (unsigned char*)d_ws;
    hipLaunchKernelGGL(mk_fwd, dim3(grid), dim3(512), LDS_BYTES, stream, p);
    const hipError_t le = hipPeekAtLastError();
    if (le != hipSuccess) fprintf(stderr, "kernel_launch: launch failed: %s\n", hipGetErrorName(le));
}
```
